# Optimizing an MI355X kernel written in HIP

```python
import jax, jax.numpy as jnp
from jax import lax
import numpy as np

D_MODEL = 2048
BATCH = 4
SEQ = 8192
DEPTH = 1

PLE_DIM = 256
M_HEADS = 4
M_QK_DIM = 128
M_V_DIM = 256
M_CONV = 4
M_CHUNK = 64
F_BIAS_LO = 3.0
F_BIAS_HI = 6.0
A_HEADS = 8
A_HEAD_DIM = 128
MOBA_BLOCK = 256
MOBA_TOPK = 3
A_QCHUNK = 16
ROPE_THETA = 500000.0
ROPE_DIM = A_HEAD_DIM // 4
D_FF = 4 * D_MODEL
EPS = 1e-6

M_QK_W = M_HEADS * M_QK_DIM
M_V_W = M_HEADS * M_V_DIM
A_W = A_HEADS * A_HEAD_DIM
SPLITS = (M_QK_W, M_QK_W, M_V_W, M_V_W, M_HEADS, M_HEADS, A_W, A_W, A_W, D_MODEL, D_MODEL)
IN_WIDTH = M_QK_W * 2 + M_V_W * 2 + M_HEADS * 2 + A_W * 3 + D_MODEL * 2

kernel_name = 'hybrid_mlstm_moba_block'


def rmsnorm(x, g):
    x32 = x.astype(jnp.float32)
    y = x32 * lax.rsqrt(jnp.mean(x32 * x32, axis=-1, keepdims=True) + EPS)
    return (y * g.astype(jnp.float32)).astype(x.dtype)


def to_heads(t, n):
    b, s, _ = t.shape
    return t.reshape(b, s, n, -1).transpose(0, 2, 1, 3)


def causal_dwconv(x, w, b):
    y = lax.conv_general_dilated(
        x, w[:, None, :].astype(x.dtype), window_strides=(1,), padding=[(M_CONV - 1, 0)],
        dimension_numbers=('NWC', 'WIO', 'NWC'), feature_group_count=x.shape[-1])
    return y + b.astype(x.dtype)


def partial_rope(x, positions):
    half = ROPE_DIM // 2
    inv_freq = ROPE_THETA ** (-jnp.arange(half, dtype=jnp.float32) * 2.0 / ROPE_DIM)
    ang = positions.astype(jnp.float32)[:, None, :, None] * inv_freq
    cos, sin = jnp.cos(ang), jnp.sin(ang)
    xr = x[..., :ROPE_DIM].astype(jnp.float32)
    x1, x2 = xr[..., :half], xr[..., half:]
    rot = jnp.concatenate([x1 * cos - x2 * sin, x2 * cos + x1 * sin], axis=-1).astype(x.dtype)
    return jnp.concatenate([rot, x[..., ROPE_DIM:]], axis=-1)


def mlstm_chunkwise(q, k, v, i_pre, f_pre):
    B, H, S, dk = q.shape
    dv = v.shape[-1]
    L = M_CHUNK
    N = S // L
    qc = q.reshape(B, H, N, L, dk)
    kc = k.reshape(B, H, N, L, dk)
    vc = v.reshape(B, H, N, L, dv)
    ig = i_pre.reshape(B, H, N, L)
    bcum = jnp.cumsum(jax.nn.log_sigmoid(f_pre).reshape(B, H, N, L), axis=-1)

    def step(carry, xs):
        C, n, m = carry
        q_, k_, v_, ig_, b_ = xs
        qC = jnp.einsum('bhld,bhdv->bhlv', q_, C)
        qn = jnp.einsum('bhld,bhd->bhl', q_, n)
        g = b_[..., -1]
        a = g[..., None] - b_ + ig_
        m_new = jnp.maximum(g + m, jnp.max(a, axis=-1))
        w = jnp.exp(a - m_new[..., None])
        decay = jnp.exp(g + m - m_new)
        C = decay[..., None, None] * C + jnp.einsum('bhl,bhld,bhlv->bhdv', w, k_, v_)
        n = decay[..., None] * n + jnp.einsum('bhl,bhld->bhd', w, k_)
        return (C, n, m_new), (qC, qn, m)

    xs = (jnp.moveaxis(qc, 2, 0), jnp.moveaxis(kc, 2, 0), jnp.moveaxis(vc, 2, 0),
          jnp.moveaxis(ig, 2, 0), jnp.moveaxis(bcum, 2, 0))
    init = (jnp.zeros((B, H, dk, dv), jnp.float32), jnp.zeros((B, H, dk), jnp.float32),
            jnp.zeros((B, H), jnp.float32))
    _, (qC, qn, m_prev) = lax.scan(step, init, xs)
    qC = jnp.moveaxis(qC, 0, 2)
    qn = jnp.moveaxis(qn, 0, 2)
    m_prev = jnp.moveaxis(m_prev, 0, 2)

    causal = jnp.tril(jnp.ones((L, L), dtype=bool))
    dmat = jnp.where(causal, bcum[..., :, None] - bcum[..., None, :] + ig[..., None, :], -jnp.inf)
    inter = bcum + m_prev[..., None]
    m_t = jnp.maximum(inter, jnp.max(dmat, axis=-1))
    s = jnp.einsum('bhntd,bhnsd->bhnts', qc, kc) * jnp.exp(dmat - m_t[..., None])
    e_inter = jnp.exp(inter - m_t)
    num = e_inter[..., None] * qC + jnp.einsum('bhnts,bhnsv->bhntv', s, vc)
    den = e_inter * qn + jnp.sum(s, axis=-1)
    h = num / jnp.maximum(jnp.abs(den), jnp.exp(-m_t))[..., None]
    return h.reshape(B, H, S, dv)


def head_rmsnorm(h, g):
    B, H, S, dv = h.shape
    y = h * lax.rsqrt(jnp.mean(h * h, axis=-1, keepdims=True) + EPS)
    y = y * g.astype(jnp.float32).reshape(H, dv)[None, :, None, :]
    return y.transpose(0, 2, 1, 3).reshape(B, S, H * dv)


def moba_attention(q, k, v):
    B, H, S, Dh = q.shape
    BLK = MOBA_BLOCK
    NB = -(-S // BLK)
    S_pad = NB * BLK
    pad = ((0, 0), (0, 0), (0, S_pad - S), (0, 0))
    kb = jnp.pad(k, pad).reshape(B, H, NB, BLK, Dh)
    vb = jnp.pad(v, pad).reshape(B, H, NB, BLK, Dh)
    k_mean = jnp.mean(kb.astype(jnp.float32), axis=3)
    scores = jnp.einsum('bhsd,bhnd->bhsn', q.astype(jnp.float32), k_mean)
    q_blk = jnp.arange(S) // BLK
    fully_past = jnp.arange(NB)[None, :] < q_blk[:, None]
    scores = jnp.where(fully_past, scores, -jnp.inf)
    K_SEL = min(MOBA_TOPK, NB)
    _, idx = lax.top_k(scores, K_SEL)

    QC = A_QCHUNK
    Nq = S // QC
    q_ch = jnp.moveaxis(q.reshape(B, H, Nq, QC, Dh), 2, 0)
    idx_ch = jnp.moveaxis(idx.reshape(B, H, Nq, QC, K_SEL), 2, 0)
    starts = jnp.arange(Nq, dtype=jnp.int32) * QC
    bi = jnp.arange(B)[:, None, None, None]
    hi = jnp.arange(H)[None, :, None, None]
    scale = Dh ** -0.5

    def one_chunk(args):
        q_c, idx_c, start = args
        c = start // BLK
        k_sel = kb[bi, hi, idx_c]
        v_sel = vb[bi, hi, idx_c]
        k_own = lax.dynamic_index_in_dim(kb, c, axis=2, keepdims=False)
        v_own = lax.dynamic_index_in_dim(vb, c, axis=2, keepdims=False)
        lp = jnp.einsum('bhqd,bhqjld->bhqjl', q_c, k_sel).astype(jnp.float32) * scale
        lp = jnp.where((jnp.arange(K_SEL) < c)[:, None], lp, -jnp.inf)
        lo = jnp.einsum('bhqd,bhld->bhql', q_c, k_own).astype(jnp.float32) * scale
        q_pos = start + jnp.arange(QC)
        k_pos = c * BLK + jnp.arange(BLK)
        lo = jnp.where(k_pos[None, :] <= q_pos[:, None], lo, -jnp.inf)
        logits = jnp.concatenate([lp.reshape(B, H, QC, K_SEL * BLK), lo], axis=-1)
        w = jax.nn.softmax(logits, axis=-1).astype(v.dtype)
        wp = w[..., :K_SEL * BLK].reshape(B, H, QC, K_SEL, BLK)
        wo = w[..., K_SEL * BLK:]
        return (jnp.einsum('bhqjl,bhqjld->bhqd', wp, v_sel)
                + jnp.einsum('bhql,bhld->bhqd', wo, v_own))

    out = lax.map(one_chunk, (q_ch, idx_ch, starts))
    return jnp.moveaxis(out, 0, 2).reshape(B, H, S, Dh)


def setup_inputs(seed: int = 0) -> dict:
    key = jax.random.key(seed)
    ks = jax.random.split(key, 24)

    def nrm(k, shape, scale):
        return jax.random.normal(k, shape, jnp.float32) * scale

    def gain(k, shape):
        return 1.0 + 0.02 * jax.random.normal(k, shape, jnp.float32)

    f_bias = jnp.linspace(F_BIAS_LO, F_BIAS_HI, M_HEADS, dtype=jnp.float32)
    b_if = jnp.stack([0.1 * jax.random.normal(ks[4], (DEPTH, M_HEADS), jnp.float32),
                      f_bias[None, :] + 0.1 * jax.random.normal(ks[5], (DEPTH, M_HEADS), jnp.float32)],
                     axis=1)
    return {
        'x': nrm(ks[0], (BATCH, SEQ, D_MODEL), 1.0),
        'p': nrm(ks[1], (DEPTH, BATCH, SEQ, PLE_DIM), 1.0),
        'positions': jnp.broadcast_to(jnp.arange(SEQ, dtype=jnp.int32), (BATCH, SEQ)),
        'attn_norm': gain(ks[2], (DEPTH, D_MODEL)),
        'w_in': nrm(ks[3], (DEPTH, D_MODEL, IN_WIDTH), D_MODEL ** -0.5),
        'b_if': b_if,
        'conv_w': nrm(ks[6], (DEPTH, M_CONV, 2 * M_QK_W), M_CONV ** -0.5),
        'conv_b': nrm(ks[7], (DEPTH, 2 * M_QK_W), 0.01),
        'm_out_norm': gain(ks[8], (DEPTH, M_V_W)),
        'w_up_m': nrm(ks[9], (DEPTH, M_V_W, D_MODEL), M_V_W ** -0.5),
        'w_up_a': nrm(ks[10], (DEPTH, A_W, D_MODEL), A_W ** -0.5),
        'w_out': nrm(ks[11], (DEPTH, D_MODEL, D_MODEL), D_MODEL ** -0.5),
        'mlp_norm': gain(ks[12], (DEPTH, D_MODEL)),
        'w_ff1': nrm(ks[13], (DEPTH, D_MODEL, D_FF), D_MODEL ** -0.5),
        'w_ff2': nrm(ks[14], (DEPTH, D_FF, D_MODEL), D_FF ** -0.5),
        'ple_norm': gain(ks[15], (DEPTH, D_MODEL)),
        'w_ple_gate': nrm(ks[16], (DEPTH, D_MODEL, D_MODEL), D_MODEL ** -0.5),
        'w_ple_proj': nrm(ks[17], (DEPTH, PLE_DIM, D_MODEL), PLE_DIM ** -0.5),
        'final_norm': gain(ks[18], (D_MODEL,)),
    }


def reference(x, p, positions, attn_norm, w_in, b_if, conv_w, conv_b, m_out_norm, w_up_m, w_up_a,
              w_out, mlp_norm, w_ff1, w_ff2, ple_norm, w_ple_gate, w_ple_proj, final_norm):
    offs = np.cumsum(np.array(SPLITS))[:-1].tolist()
    for i in range(DEPTH):
        h = rmsnorm(x, attn_norm[i])
        z = h @ w_in[i]
        mq, mk, mv, mo, mi, mf, aq, ak, av, gm, ga = jnp.split(z, offs, axis=-1)

        qk = jax.nn.silu(causal_dwconv(jnp.concatenate([mq, mk], axis=-1), conv_w[i], conv_b[i]))
        mq, mk = qk[..., :M_QK_W], qk[..., M_QK_W:]
        i_pre = (mi.astype(jnp.float32) + b_if[i, 0].astype(jnp.float32)).transpose(0, 2, 1)
        f_pre = (mf.astype(jnp.float32) + b_if[i, 1].astype(jnp.float32)).transpose(0, 2, 1)
        hm = mlstm_chunkwise(to_heads(mq, M_HEADS).astype(jnp.float32),
                             to_heads(mk, M_HEADS).astype(jnp.float32) * (M_QK_DIM ** -0.5),
                             to_heads(mv, M_HEADS).astype(jnp.float32), i_pre, f_pre)
        hm = head_rmsnorm(hm, m_out_norm[i]).astype(x.dtype) * jax.nn.sigmoid(mo)

        qa = partial_rope(to_heads(aq, A_HEADS), positions)
        ka = partial_rope(to_heads(ak, A_HEADS), positions)
        va = to_heads(av, A_HEADS)
        ha = moba_attention(qa, ka, va)
        ha = ha.transpose(0, 2, 1, 3).reshape(x.shape[0], x.shape[1], A_W)

        merged = (jax.nn.sigmoid(gm) * (hm @ w_up_m[i])
                  + jax.nn.sigmoid(ga) * (ha @ w_up_a[i]))
        x = x + merged @ w_out[i]

        h = rmsnorm(x, mlp_norm[i])
        x = x + jnp.square(jax.nn.relu(h @ w_ff1[i])) @ w_ff2[i]

        h = rmsnorm(x, ple_norm[i])
        x = x + jax.nn.sigmoid(h @ w_ple_gate[i]) * (p[i] @ w_ple_proj[i])
    return rmsnorm(x, final_norm)
```

```cpp
#include <hip/hip_runtime.h>
#include <hip/hip_cooperative_groups.h>
#include <cstdio>
#include <cstdint>
namespace cg = cooperative_groups;
namespace pg8 {
#define PG8_LAS __attribute__((address_space(3)))
typedef unsigned short bf16_t;
typedef short bf16x8 __attribute__((ext_vector_type(8)));
typedef float f32x4 __attribute__((ext_vector_type(4)));
typedef unsigned u32x4 __attribute__((ext_vector_type(4)));
constexpr int BM = 256, BK = 64, HALF = 128, HTB = HALF * BK * 2  , STAGE_BYTES = 8 * HTB, NXCD = 8, WGM = 4;

__host__ __device__ __forceinline__ int lds_byte(int r, int c) { const int st = (r >> 4) * 2 + (c >> 5), rr = r & 15, cc = c & 31, ob = rr * 64 + cc * 2; return st * 1024 + (ob ^ (((ob >> 9) & 1) << 5)); }
__host__ __device__ __forceinline__ void stage_rc(int b, int& R, int& C) { const int st = b / 1024, sb = b % 1024, swz = sb ^ (((sb >> 9) & 1) << 5); R = (st >> 1) * 16 + swz / 64; C = (st & 1) * 32 + (swz % 64) / 2; }
__host__ __device__ __forceinline__ int perm32(int rho) { const int n = rho >> 4, i = rho & 15; return 8 * (i >> 2) + 4 * n + (i & 3); }

struct Unit { int pm, pn; };
struct Gemm { const bf16_t* A; const bf16_t* Bt; int M, N, K; };

struct StaticOrder {
    int nM, nN, nwg, G, c;
    __host__ __device__ void init(int M, int N, int G_, int c_) { nM = M / BM; nN = N / BM; nwg = nM * nN; G = G_; c = c_; }
    __host__ __device__ bool next(int i, Unit& u) const {
        const long L = (long)i * G + c; if (L >= nwg) return false;
        int wgid = (int)L; { const int q = nwg / NXCD, r = nwg % NXCD, xcd = wgid % NXCD, off = wgid / NXCD; wgid = (xcd < r ? xcd * (q + 1) : r * (q + 1) + (xcd - r) * q) + off; }
        const int nig = WGM * nN, gid = wgid / nig, fm = gid * WGM, gsz = (nM - fm) < WGM ? (nM - fm) : WGM;
        u.pm = fm + ((wgid % nig) % gsz); u.pn = (wgid % nig) / gsz; return true;
    }
    __device__ __forceinline__ void a_ready(const Unit&) const {}
    __device__ __forceinline__ void done(const Unit&) const {}
};
__device__ __forceinline__ unsigned cvt_pk_bf16(float lo, float hi) { unsigned r; asm volatile("v_cvt_pk_bf16_f32 %0, %1, %2" : "=v"(r) : "v"(lo), "v"(hi)); return r; }
__device__ __forceinline__ float bf_lo(unsigned w) { return __builtin_bit_cast(float, w << 16); }
__device__ __forceinline__ float bf_hi(unsigned w) { return __builtin_bit_cast(float, w & 0xffff0000u); }
__device__ __forceinline__ float sigm(float x) { return __builtin_amdgcn_rcpf(1.0f + __expf(-x)); }
typedef unsigned u32x2 __attribute__((ext_vector_type(2)));

enum { EM_Z = 0, EM_TMP = 1, EM_MG = 2, EM_RELU2 = 3, EM_PLAIN = 4 };
template <int MODE> struct EpiB {
    static constexpr bool PERM = true, AFTER_DRAIN = false;
    bf16_t* O; int ldc; const bf16_t* aux1; const bf16_t* aux2; size_t plane; const float* rsq_in;
    __device__ __forceinline__ void operator()(const f32x4 (&acc)[2][2][4][2], const Unit& u, int wr, int wc, int fr, int fq) const {
        const int row0 = u.pm * BM + wr * 64 + fr; int colt = u.pn * BM; bf16_t* base = O;
        if (MODE == EM_Z) { const int t = colt >> 10; base += (size_t)t * plane; colt &= 1023; }
        const int col0 = colt + wc * 32 + 8 * fq;
#pragma unroll
        for (int ai = 0; ai < 2; ++ai) {
            u32x4 gg[4][2], tt[4][2]; float rs[4];
#pragma unroll
            for (int m = 0; m < 4; ++m) { const int row = row0 + ai * HALF + m * 16;
                if (MODE == EM_RELU2) rs[m] = rsq_in[row];
#pragma unroll
                for (int bj = 0; bj < 2; ++bj) {
                    if (MODE == EM_TMP || MODE == EM_MG) { const int gc = u.pn * BM + bj * HALF + wc * 32 + 8 * fq;
                        gg[m][bj] = *(const u32x4*)(aux1 + (size_t)(gc >> 10) * plane + (size_t)row * 1024 + (gc & 1023)); }
                    if (MODE == EM_MG) tt[m][bj] = *(const u32x4*)(aux2 + (size_t)row * ldc + col0 + bj * HALF); } }
#pragma unroll
            for (int m = 0; m < 4; ++m) { const size_t ro = (size_t)(row0 + ai * HALF + m * 16) * ldc + col0;
#pragma unroll
                for (int bj = 0; bj < 2; ++bj) { f32x4 v0 = acc[ai][bj][m][0], v1 = acc[ai][bj][m][1];
                    const size_t off = ro + bj * HALF;
                    if (MODE == EM_TMP || MODE == EM_MG) { const u32x4 g = gg[m][bj];
                        float s0 = sigm(bf_lo(g.x)), s1 = sigm(bf_hi(g.x)), s2 = sigm(bf_lo(g.y)), s3 = sigm(bf_hi(g.y));
                        float s4 = sigm(bf_lo(g.z)), s5 = sigm(bf_hi(g.z)), s6 = sigm(bf_lo(g.w)), s7 = sigm(bf_hi(g.w));
                        v0 = (f32x4){v0[0] * s0, v0[1] * s1, v0[2] * s2, v0[3] * s3}; v1 = (f32x4){v1[0] * s4, v1[1] * s5, v1[2] * s6, v1[3] * s7};
                        if (MODE == EM_MG) { const u32x4 t = tt[m][bj];
                            v0 = (f32x4){v0[0] + bf_lo(t.x), v0[1] + bf_hi(t.x), v0[2] + bf_lo(t.y), v0[3] + bf_hi(t.y)};
                            v1 = (f32x4){v1[0] + bf_lo(t.z), v1[1] + bf_hi(t.z), v1[2] + bf_lo(t.w), v1[3] + bf_hi(t.w)}; }
                    }
                    if (MODE == EM_RELU2) { const float rin = rsqrtf(rs[m] * (1.0f / 2048.0f) + 1e-6f);
#pragma unroll
                        for (int j = 0; j < 4; ++j) { float a = fmaxf(v0[j], 0.f) * rin, b = fmaxf(v1[j], 0.f) * rin; v0[j] = a * a; v1[j] = b * b; } }
                    u32x4 w; w.x = cvt_pk_bf16(v0[0], v0[1]); w.y = cvt_pk_bf16(v0[2], v0[3]); w.z = cvt_pk_bf16(v1[0], v1[1]); w.w = cvt_pk_bf16(v1[2], v1[3]);
                    *(u32x4*)(base + off) = w; } } }
    }
};
enum { EF_RES = 0, EF_PLE = 1 };
template <int MODE, bool NORM, bool RESB = false, bool OUTB = false> struct EpiF {
    static constexpr bool PERM = false, AFTER_DRAIN = false;
    float* O; const float* res; const bf16_t* pp; int ldc; bf16_t* hb; const float* gvec; float* rsq; const float* rsq_in; bf16_t* Ob; const bf16_t* resb;
    __device__ __forceinline__ void operator()(const f32x4 (&acc)[2][2][4][2], const Unit& u, int wr, int wc, int fr, int fq) const {
        const int row0 = u.pm * BM + wr * 64 + fr, col0 = u.pn * BM + wc * 32 + 4 * fq;
        f32x4 gv[2][2];
        if (NORM) {
#pragma unroll
            for (int bj = 0; bj < 2; ++bj)
#pragma unroll
                for (int n = 0; n < 2; ++n) gv[bj][n] = *(const f32x4*)(gvec + col0 + bj * HALF + n * 16); }
#pragma unroll
        for (int ai = 0; ai < 2; ++ai)
#pragma unroll
            for (int mh = 0; mh < 2; ++mh) {
                f32x4 rr[2][2][2]; u32x2 qq[2][2][2]; float rin[2] = {1.f, 1.f};
#pragma unroll
                for (int mi = 0; mi < 2; ++mi) { const int row = row0 + ai * HALF + (mh * 2 + mi) * 16; const size_t ro = (size_t)row * ldc + col0;
                    if (MODE == EF_PLE) rin[mi] = rsq_in[row];
#pragma unroll
                    for (int bj = 0; bj < 2; ++bj)
#pragma unroll
                        for (int n = 0; n < 2; ++n) { const size_t off = ro + bj * HALF + n * 16;
                            if (RESB) { const u32x2 t2 = *(const u32x2*)(resb + off); rr[mi][bj][n] = (f32x4){bf_lo(t2.x), bf_hi(t2.x), bf_lo(t2.y), bf_hi(t2.y)}; }
                            else rr[mi][bj][n] = *(const f32x4*)(res + off);
                            if (MODE == EF_PLE) qq[mi][bj][n] = *(const u32x2*)(pp + off); } }
#pragma unroll
                for (int mi = 0; mi < 2; ++mi) { const int m = mh * 2 + mi; const int row = row0 + ai * HALF + m * 16; const size_t ro = (size_t)row * ldc + col0;
                    const float rn = (MODE == EF_PLE) ? rsqrtf(rin[mi] * (1.0f / 2048.0f) + 1e-6f) : 1.f;
                    float ss = 0.f;
#pragma unroll
                    for (int bj = 0; bj < 2; ++bj)
#pragma unroll
                        for (int n = 0; n < 2; ++n) { const size_t off = ro + bj * HALF + n * 16;
                            f32x4 v = acc[ai][bj][m][n];
                            if (MODE == EF_PLE) { const u32x2 q = qq[mi][bj][n];
                                v = (f32x4){sigm(v[0] * rn) * bf_lo(q.x), sigm(v[1] * rn) * bf_hi(q.x), sigm(v[2] * rn) * bf_lo(q.y), sigm(v[3] * rn) * bf_hi(q.y)}; }
                            const f32x4 o = rr[mi][bj][n] + v;
                            if (OUTB) { u32x2 wo; wo.x = cvt_pk_bf16(o[0], o[1]); wo.y = cvt_pk_bf16(o[2], o[3]); *(u32x2*)(Ob + off) = wo; }
                            else *(f32x4*)(O + off) = o;
                            if (NORM) { ss += o[0] * o[0] + o[1] * o[1] + o[2] * o[2] + o[3] * o[3];
                                const f32x4 h = o * gv[bj][n]; u32x2 w; w.x = cvt_pk_bf16(h[0], h[1]); w.y = cvt_pk_bf16(h[2], h[3]); *(u32x2*)(hb + off) = w; } }
                    if (NORM) { ss += __shfl_xor(ss, 16); ss += __shfl_xor(ss, 32); if (fq == 0) atomicAdd(rsq + row, ss); } } }
    }
};
template <class Epi, class Sched, bool ALIGN_EPI = false, bool SP2 = false>
__device__ __forceinline__ void gemm_phase(PG8_LAS unsigned char* lds, const Gemm g, const Sched& S, const Epi& E) {
    int tid_ = threadIdx.x; asm volatile("" : "+v"(tid_));
    const int tid = tid_, wid = __builtin_amdgcn_readfirstlane(tid >> 6), lane = tid & 63, wr = wid >> 2, wc = wid & 3, fr = lane & 15, fq = lane >> 4;
    int K_ = g.K; asm volatile("" : "+s"(K_)); const int K = K_, nt = K / BK;
    unsigned voffA[2], voffB[2];
#pragma unroll
    for (int i = 0; i < 2; ++i) { int R, C; stage_rc(tid * 16 + i * 8192, R, C); const int Rb = Epi::PERM ? ((R & ~31) + perm32(R & 31)) : R;
        voffA[i] = (unsigned)(R * K + C) * 2u; voffB[i] = (unsigned)(Rb * K + C) * 2u; }
    const size_t kstep = (size_t)(BK * 2);
    const size_t hstep = (size_t)HALF * K * 2;
    const size_t tstep = 2 * hstep;
    const unsigned ldsw = (unsigned)wid * 1024u;
    const int aoff = lds_byte(wr * 64 + fr, fq * 8), boff = lds_byte(wc * 32 + fr, fq * 8);
#define PG8_SA(b, h) (((b) * 2 + (h)) * HTB)
#define PG8_SB(b, h) ((4 + (b) * 2 + (h)) * HTB)
#define PG8_STAGE(bufoff, gbase, voff) do { _Pragma("unroll") for (int _i = 0; _i < 2; ++_i) \
        __builtin_amdgcn_global_load_lds((const unsigned*)((const char*)(gbase) + (voff)[_i]), (PG8_LAS unsigned*)(lds + (bufoff) + ldsw + _i * 8192), 16, 0, 0); } while (0)
#define PG8_LDA(dst, b, h) do { _Pragma("unroll") for (int m = 0; m < 4; ++m) _Pragma("unroll") for (int k = 0; k < 2; ++k) dst[m][k] = *(const PG8_LAS bf16x8*)(lds + PG8_SA(b, h) + aoff + m * 2048 + k * 1024); } while (0)
#define PG8_LDB(dst, b, h) do { _Pragma("unroll") for (int n = 0; n < 2; ++n) _Pragma("unroll") for (int k = 0; k < 2; ++k) dst[n][k] = *(const PG8_LAS bf16x8*)(lds + PG8_SB(b, h) + boff + n * 2048 + k * 1024); } while (0)
#define PG8_MMA(ai, bj, At, Bt) do { __builtin_amdgcn_s_setprio(1); _Pragma("unroll") for (int m = 0; m < 4; ++m) _Pragma("unroll") for (int n = 0; n < 2; ++n) _Pragma("unroll") for (int k = 0; k < 2; ++k) \
        acc[ai][bj][m][n] = __builtin_amdgcn_mfma_f32_16x16x32_bf16(Bt[n][k], At[m][k], acc[ai][bj][m][n], 0, 0, 0); __builtin_amdgcn_s_setprio(0); } while (0)
#define PG8_WAIT_V(n) asm volatile("s_waitcnt vmcnt(" #n ")" ::: "memory")
#define PG8_WAIT_L(n) asm volatile("s_waitcnt lgkmcnt(" #n ")" ::: "memory")
#define PG8_BAR __builtin_amdgcn_s_barrier()
#define PG8_SCHED __builtin_amdgcn_sched_barrier(0)
    Unit cur, nxt; int ui = 0;
    if (!S.next(0, cur)) return;
    f32x4 acc[2][2][4][2];
#pragma unroll
    for (int a = 0; a < 2; ++a)
#pragma unroll
        for (int b = 0; b < 2; ++b)
#pragma unroll
            for (int m = 0; m < 4; ++m)
#pragma unroll
                for (int n = 0; n < 2; ++n) acc[a][b][m][n] = (f32x4){0.f, 0.f, 0.f, 0.f};
    bf16x8 At[4][2], B0[2][2], B1[2][2];
    const char* cA = (const char*)g.A + (size_t)cur.pm * tstep; const char* cB = (const char*)g.Bt + (size_t)cur.pn * tstep;
    S.a_ready(cur);
    if constexpr (SP2) {
        PG8_STAGE(PG8_SB(0, 0), cB, voffB); PG8_STAGE(PG8_SB(0, 1), cB + hstep, voffB); PG8_STAGE(PG8_SA(0, 0), cA, voffA); PG8_STAGE(PG8_SA(0, 1), cA + hstep, voffA);
        if (wr == 1) PG8_BAR;
        PG8_WAIT_V(2); PG8_BAR;
        PG8_STAGE(PG8_SB(1, 0), cB + kstep, voffB); PG8_STAGE(PG8_SA(1, 0), cA + kstep, voffA); PG8_STAGE(PG8_SB(1, 1), cB + hstep + kstep, voffB);
        PG8_WAIT_V(6); PG8_BAR;
    } else {
        PG8_STAGE(PG8_SB(0, 0), cB, voffB); PG8_STAGE(PG8_SA(0, 0), cA, voffA); PG8_STAGE(PG8_SB(0, 1), cB + hstep, voffB); PG8_STAGE(PG8_SA(0, 1), cA + hstep, voffA);
        if (wr == 1) PG8_BAR;
        PG8_WAIT_V(4); PG8_BAR;
        PG8_STAGE(PG8_SB(1, 0), cB + kstep, voffB); PG8_STAGE(PG8_SA(1, 0), cA + kstep, voffA); PG8_STAGE(PG8_SB(1, 1), cB + hstep + kstep, voffB);
        PG8_WAIT_V(6); PG8_BAR;
    }
    for (;;) {
        const bool has_next = S.next(ui + 1, nxt);
        const char* nA = has_next ? (const char*)g.A + (size_t)nxt.pm * tstep : cA; const char* nB = has_next ? (const char*)g.Bt + (size_t)nxt.pn * tstep : cB;
        for (int t = 0; t < nt; t += 2) {
            const bool last = (t == nt - 2);
            const char* a1 = cA + (size_t)(t + 1) * kstep;
            const char* a2 = last ? nA : cA + (size_t)(t + 2) * kstep; const char* b2 = last ? nB : cB + (size_t)(t + 2) * kstep;
            const char* a3 = a2 + kstep; const char* b3 = b2 + kstep;
            if (last && has_next) S.a_ready(nxt);
            if constexpr (SP2) {
            PG8_LDB(B0, 0, 0); PG8_LDB(B1, 0, 1); PG8_SCHED; PG8_LDA(At, 0, 0); PG8_STAGE(PG8_SA(1, 1), a1 + hstep, voffA);
            PG8_WAIT_V(8); PG8_WAIT_L(0); PG8_BAR; PG8_MMA(0, 0, At, B0); PG8_MMA(0, 1, At, B1); PG8_BAR; PG8_SCHED;
            PG8_LDA(At, 0, 1); PG8_STAGE(PG8_SB(0, 0), b2, voffB); PG8_STAGE(PG8_SB(0, 1), b2 + hstep, voffB); PG8_STAGE(PG8_SA(0, 0), a2, voffA);
            PG8_WAIT_V(8); PG8_WAIT_L(0); PG8_BAR; PG8_MMA(1, 0, At, B0); PG8_MMA(1, 1, At, B1); PG8_BAR; PG8_SCHED;
            PG8_LDB(B0, 1, 0); PG8_LDB(B1, 1, 1); PG8_SCHED; PG8_LDA(At, 1, 0); PG8_STAGE(PG8_SA(0, 1), a2 + hstep, voffA);
            PG8_WAIT_V(8); PG8_WAIT_L(0); PG8_BAR; PG8_MMA(0, 0, At, B0); PG8_MMA(0, 1, At, B1); PG8_BAR; PG8_SCHED;
            PG8_LDA(At, 1, 1); PG8_STAGE(PG8_SB(1, 0), b3, voffB); PG8_STAGE(PG8_SB(1, 1), b3 + hstep, voffB); PG8_STAGE(PG8_SA(1, 0), a3, voffA);
            PG8_WAIT_V(8); PG8_WAIT_L(0); PG8_BAR; PG8_MMA(1, 0, At, B0); PG8_MMA(1, 1, At, B1); PG8_BAR; PG8_SCHED;
            } else {
            PG8_LDB(B0, 0, 0); PG8_SCHED; PG8_LDA(At, 0, 0); PG8_STAGE(PG8_SA(1, 1), a1 + hstep, voffA);
            PG8_WAIT_L(8); PG8_BAR; PG8_WAIT_L(0); PG8_MMA(0, 0, At, B0); PG8_BAR; PG8_SCHED;
            PG8_LDB(B1, 0, 1); PG8_STAGE(PG8_SB(0, 0), b2, voffB);
            PG8_BAR; PG8_WAIT_L(0); PG8_MMA(0, 1, At, B1); PG8_BAR;
            PG8_LDA(At, 0, 1); PG8_STAGE(PG8_SA(0, 0), a2, voffA);
            PG8_BAR; PG8_WAIT_L(0); PG8_MMA(1, 0, At, B0); PG8_BAR; PG8_SCHED;
            PG8_STAGE(PG8_SB(0, 1), b2 + hstep, voffB);
            PG8_WAIT_V(6); PG8_BAR; PG8_MMA(1, 1, At, B1); PG8_BAR;
            PG8_LDB(B0, 1, 0); PG8_SCHED; PG8_LDA(At, 1, 0); PG8_STAGE(PG8_SA(0, 1), a2 + hstep, voffA);
            PG8_WAIT_L(8); PG8_BAR; PG8_WAIT_L(0); PG8_MMA(0, 0, At, B0); PG8_BAR; PG8_SCHED;
            PG8_LDB(B1, 1, 1); PG8_STAGE(PG8_SB(1, 0), b3, voffB);
            PG8_BAR; PG8_WAIT_L(0); PG8_MMA(0, 1, At, B1); PG8_BAR;
            PG8_LDA(At, 1, 1); PG8_STAGE(PG8_SA(1, 0), a3, voffA);
            PG8_BAR; PG8_WAIT_L(0); PG8_MMA(1, 0, At, B0); PG8_BAR; PG8_SCHED;
            PG8_STAGE(PG8_SB(1, 1), b3 + hstep, voffB);
            PG8_WAIT_V(6); PG8_BAR; PG8_MMA(1, 1, At, B1); PG8_BAR;
            }
        }
        if constexpr (ALIGN_EPI) { if (wr == 0) PG8_BAR; }
        if constexpr (!Epi::AFTER_DRAIN) { E(acc, cur, wr, wc, fr, fq); S.done(cur); }
        if (!has_next) break;
#pragma unroll
        for (int a = 0; a < 2; ++a)
#pragma unroll
            for (int b = 0; b < 2; ++b)
#pragma unroll
                for (int m = 0; m < 4; ++m)
#pragma unroll
                    for (int n = 0; n < 2; ++n) acc[a][b][m][n] = (f32x4){0.f, 0.f, 0.f, 0.f};
        cur = nxt; cA = nA; cB = nB; ++ui;
        if constexpr (ALIGN_EPI) { if (wr == 1) PG8_BAR; }
    }
    PG8_WAIT_V(0);
    if constexpr (!ALIGN_EPI) { if (wr == 0) PG8_BAR; }
    PG8_BAR;
    if constexpr (Epi::AFTER_DRAIN) { E.fused(acc, cur, wr, wc, fr, fq, lds, wid, lane); S.done(cur); }
#undef PG8_SA
#undef PG8_SB
#undef PG8_STAGE
#undef PG8_LDA
#undef PG8_LDB
#undef PG8_MMA
#undef PG8_WAIT_V
#undef PG8_WAIT_L
#undef PG8_BAR
#undef PG8_SCHED
}
}

typedef unsigned short bf16_t;
typedef short bf16x8 __attribute__((ext_vector_type(8)));
typedef float f32x4 __attribute__((ext_vector_type(4)));
typedef unsigned u32x4 __attribute__((ext_vector_type(4)));
typedef unsigned u32x2 __attribute__((ext_vector_type(2)));
using pg8::cvt_pk_bf16; using pg8::bf_lo; using pg8::bf_hi; using pg8::sigm;

constexpr int NB_ = 4, SEQ_ = 8192, T_ = NB_ * SEQ_, DM = 2048, DFF = 8192, INW = 10248, NZ = 10240;
constexpr float EPS_ = 1e-6f;
constexpr size_t MiB = 1u << 20;
constexpr size_t WS_RSQ1 = 0, WS_RSQ2 = (size_t)T_ * 4, WS_XBAR = 512 * 1024;
constexpr size_t WS_IF = 1 * MiB, WS_CS = 2 * MiB, WS_KM = 6 * MiB, WS_SEL = 7 * MiB, WS_LSE = 8 * MiB, WS_PB = 12 * MiB;
constexpr size_t WS_WIN = 28 * MiB, WS_WM = 68 * MiB, WS_WA = 72 * MiB, WS_WOUT = 76 * MiB, WS_W1 = 84 * MiB, WS_W2 = 116 * MiB, WS_WG = 148 * MiB, WS_WP = 156 * MiB;
constexpr size_t WS_XN = 160 * MiB, WS_HM = 160 * MiB, WS_HU = 224 * MiB, WS_QKC = 160 * MiB;
constexpr size_t WS_Z = 288 * MiB, PLANE = (size_t)T_ * 1024;
constexpr size_t WS_X1B = WS_Z + 512 * MiB;
constexpr size_t WS_HA = WS_Z, WS_TMP = WS_Z + 64 * MiB, WS_MG = WS_Z + 192 * MiB, WS_U = WS_Z, WS_PP = WS_Z + 512 * MiB;
constexpr size_t WS_GB = 928 * MiB, WS_GU = WS_GB + 512 * 1024, WS_GCM = WS_GU + 512 * 1024;
constexpr size_t WS_DUMP = 930 * MiB;
constexpr size_t WS_LG = 931 * MiB, WS_CI = 965 * MiB, WS_LD = 999 * MiB;
constexpr size_t WS_END = 1000 * MiB;
constexpr int LDS_BYTES = 163840;
enum { PL_QK = 0, PL_MV = 1, PL_MO = 2, PL_AQ = 3, PL_AK = 4, PL_AV = 5, PL_GM = 6, PL_GA = 8 };

struct Params {
    const float* x; const float* p; const int* positions; const float* attn_norm; const float* w_in; const float* b_if; const float* conv_w; const float* conv_b;
    const float* m_out_norm; const float* w_up_m; const float* w_up_a; const float* w_out; const float* mlp_norm; const float* w_ff1; const float* w_ff2;
    const float* ple_norm; const float* w_ple_gate; const float* w_ple_proj; const float* final_norm;
    float* out; unsigned char* ws;
};

__device__ __forceinline__ int opaque_tid() { int t_ = threadIdx.x; asm volatile("" : "+v"(t_)); return t_; }
__device__ __forceinline__ float wave_sum(float v) {
#pragma unroll
    for (int o = 32; o > 0; o >>= 1) v += __shfl_xor(v, o);
    return v;
}

#define LBAR() do { asm volatile("s_waitcnt lgkmcnt(0)" ::: "memory"); __builtin_amdgcn_s_barrier(); asm volatile("" ::: "memory"); } while (0)
template <int K, int N, int LDS_, bool WIN> __device__ __forceinline__ void wmat(const float* src, bf16_t* dst, int base, unsigned char* lds) {
    const int tid = threadIdx.x; constexpr int LD = 260, nN = N / 256, NT = nN * (K / 64);
    float* tl0 = (float*)lds; float* tl1 = tl0 + 64 * LD;
    const int G = gridDim.x; int t = ((int)blockIdx.x - base % G + G) % G;
    float4 r0, r1, r2, r3, r4, r5, r6, r7;
#define WLOAD(tt_) do { const int k0_ = ((tt_) / nN) * 64, n0_ = ((tt_) % nN) * 256; const float* b_ = src + (size_t)(k0_ + (tid >> 6)) * LDS_ + ((WIN && n0_ >= 3072) ? 8 : 0) + n0_ + (tid & 63) * 4; constexpr size_t st_ = (size_t)8 * LDS_; \
        r0 = *(const float4*)b_; r1 = *(const float4*)(b_ + st_); r2 = *(const float4*)(b_ + 2 * st_); r3 = *(const float4*)(b_ + 3 * st_); \
        r4 = *(const float4*)(b_ + 4 * st_); r5 = *(const float4*)(b_ + 5 * st_); r6 = *(const float4*)(b_ + 6 * st_); r7 = *(const float4*)(b_ + 7 * st_); } while (0)
    if (t < NT) WLOAD(t);
    int par = 0;
    for (; t < NT; t += G) {
        float* tl = par ? tl1 : tl0;
        { float* wp = tl + (tid >> 6) * LD + (tid & 63) * 4;
          *(float4*)wp = r0; *(float4*)(wp + 8 * LD) = r1; *(float4*)(wp + 16 * LD) = r2; *(float4*)(wp + 24 * LD) = r3;
          *(float4*)(wp + 32 * LD) = r4; *(float4*)(wp + 40 * LD) = r5; *(float4*)(wp + 48 * LD) = r6; *(float4*)(wp + 56 * LD) = r7; }
        if (t + G < NT) WLOAD(t + G);
        LBAR();
        { const int nn = tid & 255, k0 = (t / nN) * 64, n0 = (t % nN) * 256;
#pragma unroll
          for (int i = 0; i < 4; ++i) { const int k8 = ((tid >> 8) + 2 * i) * 8; const float* rp = tl + k8 * LD + nn;
              u32x4 w; w.x = cvt_pk_bf16(rp[0], rp[LD]); w.y = cvt_pk_bf16(rp[2 * LD], rp[3 * LD]); w.z = cvt_pk_bf16(rp[4 * LD], rp[5 * LD]); w.w = cvt_pk_bf16(rp[6 * LD], rp[7 * LD]);
              *(u32x4*)(dst + (size_t)(n0 + nn) * K + k0 + k8) = w; } }
        par ^= 1;
    }
#undef WLOAD
    __syncthreads();
}
__device__ void weights_phase(const Params& P, unsigned char* lds) {
    unsigned char* ws = P.ws;
    wmat<2048, NZ, INW, true>(P.w_in, (bf16_t*)(ws + WS_WIN), 0, lds);
    wmat<2048, 8192, 8192, false>(P.w_ff1, (bf16_t*)(ws + WS_W1), 1280, lds);
    wmat<8192, 2048, 2048, false>(P.w_ff2, (bf16_t*)(ws + WS_W2), 2304, lds);
    wmat<2048, 2048, 2048, false>(P.w_out, (bf16_t*)(ws + WS_WOUT), 3328, lds);
    wmat<2048, 2048, 2048, false>(P.w_ple_gate, (bf16_t*)(ws + WS_WG), 3584, lds);
    wmat<1024, 2048, 2048, false>(P.w_up_m, (bf16_t*)(ws + WS_WM), 3840, lds);
    wmat<1024, 2048, 2048, false>(P.w_up_a, (bf16_t*)(ws + WS_WA), 3968, lds);
    wmat<256, 2048, 2048, false>(P.w_ple_proj, (bf16_t*)(ws + WS_WP), 4096, lds);
}
template <int MODE> __device__ void rms_phase(const float* X, const float* g, bf16_t* ob, float* of, const Params& P, unsigned char* lds) {
    const int tid = threadIdx.x, lane = tid & 63, wid = tid >> 6;
    float* wg = (float*)lds;
    if (MODE == 0) {
        for (int i = tid; i < 8 * 2048; i += 512) { const int c = i & 7, k = i >> 3; wg[c * 2048 + k] = P.w_in[(size_t)k * INW + 3072 + c]; }
        __syncthreads();
    }
    float4 gv[8];
#pragma unroll
    for (int j = 0; j < 8; ++j) gv[j] = *(const float4*)(g + j * 256 + lane * 4);
    for (int row = blockIdx.x * 8 + wid; row < T_; row += gridDim.x * 8) {
        const float* xr = X + (size_t)row * DM;
        float4 v[8]; float ss = 0.f;
#pragma unroll
        for (int j = 0; j < 8; ++j) { v[j] = *(const float4*)(xr + j * 256 + lane * 4); ss += v[j].x * v[j].x + v[j].y * v[j].y + v[j].z * v[j].z + v[j].w * v[j].w; }
        ss = wave_sum(ss);
        const float rinv = rsqrtf(ss * (1.0f / DM) + EPS_);
#pragma unroll
        for (int j = 0; j < 8; ++j) { v[j].x = v[j].x * rinv * gv[j].x; v[j].y = v[j].y * rinv * gv[j].y; v[j].z = v[j].z * rinv * gv[j].z; v[j].w = v[j].w * rinv * gv[j].w; }
        if (MODE == 2) {
#pragma unroll
            for (int j = 0; j < 8; ++j) *(float4*)(of + (size_t)row * DM + j * 256 + lane * 4) = v[j];
        } else {
#pragma unroll
            for (int j = 0; j < 8; ++j) { u32x2 w; w.x = cvt_pk_bf16(v[j].x, v[j].y); w.y = cvt_pk_bf16(v[j].z, v[j].w); *(u32x2*)(ob + (size_t)row * DM + j * 256 + lane * 4) = w; }
        }
        if (MODE == 0) {
            float a[8];
#pragma unroll
            for (int c = 0; c < 8; ++c) { float s = 0.f;
#pragma unroll
                for (int j = 0; j < 8; ++j) { const float4 w = *(const float4*)(wg + c * 2048 + j * 256 + lane * 4); s += v[j].x * w.x + v[j].y * w.y + v[j].z * w.z + v[j].w * w.w; }
                a[c] = wave_sum(s); }
            if (lane < 8) { float s = a[0];
#pragma unroll
                for (int c = 1; c < 8; ++c) s = (lane == c) ? a[c] : s;
                ((float*)(P.ws + WS_IF))[(size_t)row * 8 + lane] = s + P.b_if[lane]; }
        }
    }
}
__device__ void misc_prologue(const Params& P) {
    const size_t gt = (size_t)blockIdx.x * 512 + threadIdx.x, gs = (size_t)gridDim.x * 512;
    { float* z = (float*)(P.ws + WS_RSQ1); for (size_t i = gt; i < (size_t)2 * T_; i += gs) z[i] = 0.f; }
    bf16_t* pb = (bf16_t*)(P.ws + WS_PB);
    for (size_t i = gt; i < (size_t)T_ * 256 / 4; i += gs) { const float4 v = *(const float4*)(P.p + i * 4); u32x2 w; w.x = cvt_pk_bf16(v.x, v.y); w.y = cvt_pk_bf16(v.z, v.w); *(u32x2*)(pb + i * 4) = w; }
    float2* cs = (float2*)(P.ws + WS_CS);
    for (size_t i = gt; i < (size_t)T_ * 16; i += gs) { const int t = (int)(i >> 4), f = (int)(i & 15);
        const float invf = (float)pow(500000.0, -(double)f / 16.0); const float ang = (float)P.positions[t] * invf;
        float s, c; sincosf(ang, &s, &c); cs[i] = make_float2(c, s); }
}

__device__ void moba_prep_phase(const Params& P, unsigned char* lds) {
    const int tid = threadIdx.x, rr = tid >> 4, ch = tid & 15;
    float* red = (float*)lds;
    bf16_t* AQ = (bf16_t*)(P.ws + WS_Z) + PL_AQ * PLANE; bf16_t* AK = (bf16_t*)(P.ws + WS_Z) + PL_AK * PLANE;
    const float2* cs = (const float2*)(P.ws + WS_CS); float* KM = (float*)(P.ws + WS_KM);
    for (int u = blockIdx.x; u < 1024; u += gridDim.x) {
        const int b = u >> 8, j = (u >> 3) & 31, h = u & 7; const int r0 = b * SEQ_ + j * 256;
        float ks[8];
#pragma unroll
        for (int e = 0; e < 8; ++e) ks[e] = 0.f;
        for (int pb = 0; pb < 4; ++pb) {
            u32x4 wq[2], wk[2]; float4 cv[2][4]; size_t offs[2];
#pragma unroll
            for (int i = 0; i < 2; ++i) { const int row = r0 + (pb * 2 + i) * 32 + rr; offs[i] = (size_t)row * 1024 + h * 128 + ch * 8;
                wq[i] = *(const u32x4*)(AQ + offs[i]); wk[i] = *(const u32x4*)(AK + offs[i]);
                if (ch < 4) { const float4* cp = (const float4*)(cs + (size_t)row * 16 + (ch & 1) * 8);
#pragma unroll
                    for (int q4 = 0; q4 < 4; ++q4) cv[i][q4] = cp[q4]; }
                else {
#pragma unroll
                    for (int q4 = 0; q4 < 4; ++q4) cv[i][q4] = make_float4(1.f, 0.f, 1.f, 0.f); } }
#pragma unroll
            for (int i = 0; i < 2; ++i) {
#pragma unroll
                for (int which = 0; which < 2; ++which) { bf16_t* pl = which ? AK : AQ; const u32x4 w = which ? wk[i] : wq[i];
                    float x[8] = {bf_lo(w.x), bf_hi(w.x), bf_lo(w.y), bf_hi(w.y), bf_lo(w.z), bf_hi(w.z), bf_lo(w.w), bf_hi(w.w)};
                    float y[8];
#pragma unroll
                    for (int e = 0; e < 8; ++e) { const float o = __shfl_xor(x[e], 2);
                        const float4 c4 = cv[i][e >> 1]; const float cc = (e & 1) ? c4.z : c4.x, sn = (e & 1) ? c4.w : c4.y;
                        y[e] = (ch < 2) ? (x[e] * cc - o * sn) : (x[e] * cc + o * sn); }
                    if (which == 0) {
#pragma unroll
                        for (int e = 0; e < 8; ++e) y[e] *= 0.12751743074602468f;
                    } else {
#pragma unroll
                        for (int e = 0; e < 8; ++e) ks[e] += y[e];
                    }
                    u32x4 o; o.x = cvt_pk_bf16(y[0], y[1]); o.y = cvt_pk_bf16(y[2], y[3]); o.z = cvt_pk_bf16(y[4], y[5]); o.w = cvt_pk_bf16(y[6], y[7]);
                    *(u32x4*)(pl + offs[i]) = o; } } }
#pragma unroll
        for (int e = 0; e < 8; ++e) red[rr * 128 + ch * 8 + e] = ks[e];
        __syncthreads();
        if (tid < 128) { float s = 0.f;
            for (int r = 0; r < 32; ++r) s += red[r * 128 + tid];
            KM[((size_t)((b * 8 + h) * 32 + j)) * 128 + tid] = s * (1.0f / 256.0f); }
        __syncthreads();
    }
}
__device__ void moba_route_phase(const Params& P, unsigned char* lds) {
    const int tid = threadIdx.x, lane = tid & 63, wid = tid >> 6, fr = lane & 15, fq = lane >> 4;
    bf16_t* kmh = (bf16_t*)lds;
    bf16_t* kml = kmh + 32 * 136;
    float* sc = (float*)(lds + 32768);
    const bf16_t* AQ = (const bf16_t*)(P.ws + WS_Z) + PL_AQ * PLANE; const float* KM = (const float*)(P.ws + WS_KM); unsigned* SEL = (unsigned*)(P.ws + WS_SEL);
    for (int u = blockIdx.x; u < 1024; u += gridDim.x) {
        const int bh = u & 31, c = u >> 5, b = bh >> 3, h = bh & 7;
        if (c == 0) { if (tid < 256) SEL[(size_t)bh * SEQ_ + tid] = 0xFFFFFFu; continue; }
        bf16x8 qa[2][4];
#pragma unroll
        for (int mt = 0; mt < 2; ++mt) { const bf16_t* q = AQ + (size_t)(b * SEQ_ + c * 256 + wid * 32 + mt * 16 + fr) * 1024 + h * 128 + fq * 8;
#pragma unroll
            for (int ks = 0; ks < 4; ++ks) qa[mt][ks] = *(const bf16x8*)(q + ks * 32); }
        for (int i = tid; i < 32 * 128; i += 512) { const int n = i >> 7, d = i & 127; const float v = (n < c) ? KM[(size_t)bh * 32 * 128 + i] : 0.f;
            const unsigned hi = cvt_pk_bf16(v, 0.f) & 0xffffu; const float r = v - __builtin_bit_cast(float, hi << 16);
            kmh[n * 136 + d] = (bf16_t)hi; kml[n * 136 + d] = (bf16_t)(cvt_pk_bf16(r, 0.f) & 0xffffu); }
        __syncthreads();
#pragma unroll
        for (int nt = 0; nt < 2; ++nt) { bf16x8 bh_[4], bl_[4];
#pragma unroll
            for (int ks = 0; ks < 4; ++ks) { bh_[ks] = *(const bf16x8*)(kmh + (nt * 16 + fr) * 136 + ks * 32 + fq * 8); bl_[ks] = *(const bf16x8*)(kml + (nt * 16 + fr) * 136 + ks * 32 + fq * 8); }
#pragma unroll
            for (int mt = 0; mt < 2; ++mt) { f32x4 a4 = (f32x4){0.f, 0.f, 0.f, 0.f};
#pragma unroll
                for (int ks = 0; ks < 4; ++ks) { a4 = __builtin_amdgcn_mfma_f32_16x16x32_bf16(qa[mt][ks], bl_[ks], a4, 0, 0, 0); a4 = __builtin_amdgcn_mfma_f32_16x16x32_bf16(qa[mt][ks], bh_[ks], a4, 0, 0, 0); }
#pragma unroll
                for (int jj = 0; jj < 4; ++jj) sc[(wid * 32 + mt * 16 + fq * 4 + jj) * 33 + nt * 16 + fr] = a4[jj]; } }
        __syncthreads();
        if (tid < 256) { float b0 = -INFINITY, b1 = -INFINITY, b2 = -INFINITY; unsigned i0 = 0xFF, i1 = 0xFF, i2 = 0xFF;
            for (int n = 0; n < c; ++n) { const float s = sc[tid * 33 + n];
                if (s > b0) { b2 = b1; i2 = i1; b1 = b0; i1 = i0; b0 = s; i0 = n; }
                else if (s > b1) { b2 = b1; i2 = i1; b1 = s; i1 = n; }
                else if (s > b2) { b2 = s; i2 = n; } }
            SEL[(size_t)bh * SEQ_ + c * 256 + tid] = i0 | (i1 << 8) | (i2 << 16); }
        __syncthreads();
    }
}
struct MobaDef { u32x4 v[4]; float lse; bf16_t* op; float* lp; bool val; };
template <bool OWN, bool DEFER = false> __device__ __forceinline__ void moba_group(const bf16_t* Kl, const bf16_t* VTl, bf16x8 (&bq)[4], int g, int rcaus, bool valid, size_t ro, bf16_t* OP, float* LSE, int fr, int fq,
                                                                             MobaDef& D, const bf16_t* nq, bool has_next) {
#define MG_SCHED __builtin_amdgcn_sched_barrier(0)
    f32x4 acc[16];
    const bf16_t* kp = Kl + fr * 136 + fq * 8;
    bf16x8 ka[4][4];
#pragma unroll
    for (int pm = 0; pm < 3; ++pm)
#pragma unroll
        for (int ks = 0; ks < 4; ++ks) ka[pm][ks] = *(const bf16x8*)(kp + pm * 16 * 136 + ks * 32);
#pragma unroll
    for (int mt = 0; mt < 16; ++mt) {
        if (mt < 13) {
#pragma unroll
            for (int ks = 0; ks < 4; ++ks) ka[(mt + 3) & 3][ks] = *(const bf16x8*)(kp + (mt + 3) * 16 * 136 + ks * 32); }
        MG_SCHED;
        if (!OWN || mt <= g) { acc[mt] = (f32x4){0.f, 0.f, 0.f, 0.f}; __builtin_amdgcn_s_setprio(1);
#pragma unroll
            for (int ks = 0; ks < 4; ++ks) acc[mt] = __builtin_amdgcn_mfma_f32_16x16x32_bf16(ka[mt & 3][ks], bq[ks], acc[mt], 0, 0, 0);
            __builtin_amdgcn_s_setprio(0); }
        else acc[mt] = (f32x4){-INFINITY, -INFINITY, -INFINITY, -INFINITY};
        MG_SCHED; }
    if (DEFER) {
        if (D.val) {
#pragma unroll
            for (int p = 0; p < 4; ++p) *(u32x4*)(D.op + p * 32) = D.v[p];
            if (fq == 0) *D.lp = D.lse; }
        if (has_next) {
#pragma unroll
            for (int ks = 0; ks < 4; ++ks) bq[ks] = *(const bf16x8*)(nq + ks * 32); } }
    const bf16_t* vp0 = VTl + fr * 264 + fq * 8;
    u32x4 va[4][4];
#pragma unroll
    for (int s = 0; s < 3; ++s)
#pragma unroll
        for (int d = 0; d < 4; ++d) va[s][d] = *(const u32x4*)(vp0 + ((s & 1) * 4 + d) * 16 * 264 + (s >> 1) * 32);
    float mx = -INFINITY;
#pragma unroll
    for (int mt = 0; mt < 16; ++mt)
#pragma unroll
        for (int jj = 0; jj < 4; ++jj) { float s = acc[mt][jj]; if (OWN) { const int key = mt * 16 + fq * 4 + jj; s = (key > rcaus) ? -INFINITY : s; acc[mt][jj] = s; } mx = fmaxf(mx, s); }
    mx = fmaxf(mx, __shfl_xor(mx, 16)); mx = fmaxf(mx, __shfl_xor(mx, 32));
    float l = 0.f;
#pragma unroll
    for (int mt = 0; mt < 16; ++mt)
#pragma unroll
        for (int jj = 0; jj < 4; ++jj) { const float pv = __builtin_amdgcn_exp2f(acc[mt][jj] - mx); acc[mt][jj] = pv; l += pv; }
    l += __shfl_xor(l, 16); l += __shfl_xor(l, 32);
    f32x4 o[8];
#pragma unroll
    for (int dt = 0; dt < 8; ++dt) o[dt] = (f32x4){0.f, 0.f, 0.f, 0.f};
    bf16x8 pb;
#pragma unroll
    for (int s = 0; s < 16; ++s) { const int k2 = s >> 1;
        if (s < 13) {
#pragma unroll
            for (int d = 0; d < 4; ++d) va[(s + 3) & 3][d] = *(const u32x4*)(vp0 + (((s + 3) & 1) * 4 + d) * 16 * 264 + ((s + 3) >> 1) * 32); }
        MG_SCHED;
        if (!OWN || 2 * k2 <= g) {
            if ((s & 1) == 0) { u32x4 pw; pw.x = cvt_pk_bf16(acc[2 * k2][0], acc[2 * k2][1]); pw.y = cvt_pk_bf16(acc[2 * k2][2], acc[2 * k2][3]);
                pw.z = cvt_pk_bf16(acc[2 * k2 + 1][0], acc[2 * k2 + 1][1]); pw.w = cvt_pk_bf16(acc[2 * k2 + 1][2], acc[2 * k2 + 1][3]);
                pb = __builtin_bit_cast(bf16x8, pw); }
            __builtin_amdgcn_s_setprio(1);
#pragma unroll
            for (int d = 0; d < 4; ++d) o[(s & 1) * 4 + d] = __builtin_amdgcn_mfma_f32_16x16x32_bf16(__builtin_bit_cast(bf16x8, va[s & 3][d]), pb, o[(s & 1) * 4 + d], 0, 0, 0);
            __builtin_amdgcn_s_setprio(0); }
        MG_SCHED; }
    {
      const float inv = __builtin_amdgcn_rcpf(l);
      u32x2 w[8];
#pragma unroll
      for (int dt = 0; dt < 8; ++dt) { w[dt].x = cvt_pk_bf16(o[dt][0] * inv, o[dt][1] * inv); w[dt].y = cvt_pk_bf16(o[dt][2] * inv, o[dt][3] * inv); }
      bf16_t* op = OP + ro * 128 + ((fq & 1) ? 16 + (fq - 1) * 4 : fq * 4);
#pragma unroll
      for (int p = 0; p < 4; ++p) { const u32x2 rx = __builtin_amdgcn_permlane16_swap(w[2 * p].x, w[2 * p + 1].x, false, false), ry = __builtin_amdgcn_permlane16_swap(w[2 * p].y, w[2 * p + 1].y, false, false);
          u32x4 v; v.x = rx[0]; v.y = ry[0]; v.z = rx[1]; v.w = ry[1];
          if (DEFER) D.v[p] = v; else if (valid) *(u32x4*)(op + p * 32) = v; }
      const float lse2 = mx + __builtin_amdgcn_logf(l);
      if (DEFER) { D.op = op; D.lp = LSE + ro; D.lse = lse2; D.val = valid; } else if (valid && fq == 0) LSE[ro] = lse2; }
#undef MG_SCHED
}
__device__ void moba_unit(const Params& P, int b, int h, int j, unsigned char* lds) {
    const int tid = threadIdx.x, lane = tid & 63, wid = tid >> 6, fr = lane & 15, fq = lane >> 4;
    bf16_t* Kl = (bf16_t*)lds;
    bf16_t* VTl = (bf16_t*)(lds + 69632);
    unsigned short* list = (unsigned short*)(lds + 139264);
    int* cnt = (int*)(lds + 139264 + 15872);
    const bf16_t* AQ = (const bf16_t*)(P.ws + WS_Z) + PL_AQ * PLANE; const bf16_t* AK = (const bf16_t*)(P.ws + WS_Z) + PL_AK * PLANE; const bf16_t* AV = (const bf16_t*)(P.ws + WS_Z) + PL_AV * PLANE;
    const unsigned* SEL = (const unsigned*)(P.ws + WS_SEL); float* LSE = (float*)(P.ws + WS_LSE); bf16_t* OP = (bf16_t*)P.out;
    const int bh = b * 8 + h; const size_t base = (size_t)b * SEQ_ + (size_t)j * 256;
    __syncthreads();
    if (tid == 0) *cnt = 0;
    { const int r = tid >> 1, hf = tid & 1; const size_t go = (base + r) * 1024 + h * 128 + hf * 64;
      const int cr = (r & ~31) | (((r >> 2) & 3) << 3) | (((r >> 4) & 1) << 2) | (r & 3);
      u32x4 kv[8], vv[8];
#pragma unroll
      for (int i = 0; i < 8; ++i) { kv[i] = *(const u32x4*)(AK + go + i * 8); vv[i] = *(const u32x4*)(AV + go + i * 8); }
#pragma unroll
      for (int i = 0; i < 8; ++i) *(u32x4*)(Kl + r * 136 + hf * 64 + i * 8) = kv[i];
#pragma unroll
      for (int i = 0; i < 8; ++i) { const int d0 = hf * 64 + i * 8;
          VTl[(d0 + 0) * 264 + cr] = (bf16_t)(vv[i].x & 0xffff); VTl[(d0 + 1) * 264 + cr] = (bf16_t)(vv[i].x >> 16);
          VTl[(d0 + 2) * 264 + cr] = (bf16_t)(vv[i].y & 0xffff); VTl[(d0 + 3) * 264 + cr] = (bf16_t)(vv[i].y >> 16);
          VTl[(d0 + 4) * 264 + cr] = (bf16_t)(vv[i].z & 0xffff); VTl[(d0 + 5) * 264 + cr] = (bf16_t)(vv[i].z >> 16);
          VTl[(d0 + 6) * 264 + cr] = (bf16_t)(vv[i].w & 0xffff); VTl[(d0 + 7) * 264 + cr] = (bf16_t)(vv[i].w >> 16); } }
    __syncthreads();
    for (int t0 = (j + 1) * 256 + tid; t0 < SEQ_; t0 += 2048) {
        unsigned sv[4];
#pragma unroll
        for (int q = 0; q < 4; ++q) { const int t = t0 + q * 512; sv[q] = (t < SEQ_) ? SEL[(size_t)bh * SEQ_ + t] : 0xFFFFFFFFu; }
#pragma unroll
        for (int q = 0; q < 4; ++q) { const unsigned s = sv[q]; const int t = t0 + q * 512;
            const int sl = ((s & 0xFF) == (unsigned)j) ? 0 : (((s >> 8) & 0xFF) == (unsigned)j) ? 1 : (((s >> 16) & 0xFF) == (unsigned)j) ? 2 : -1;
            if (sl >= 0 && t < SEQ_) { const int pos = atomicAdd(cnt, 1); list[pos] = (unsigned short)(t | (sl << 13)); } } }
    __syncthreads();
    const int nl = *cnt, NGg = (nl + 15) / 16;
    const size_t qb = (size_t)b * SEQ_;
    { bf16x8 bq[4], bn[4]; MobaDef D0; D0.val = false;
      { const bf16_t* qrow = AQ + (qb + j * 256 + wid * 16 + fr) * 1024 + h * 128;
#pragma unroll
        for (int ks = 0; ks < 4; ++ks) bq[ks] = *(const bf16x8*)(qrow + ks * 32 + fq * 8); }
      { const bf16_t* qrow = AQ + (qb + j * 256 + (wid + 8) * 16 + fr) * 1024 + h * 128;
#pragma unroll
        for (int ks = 0; ks < 4; ++ks) bn[ks] = *(const bf16x8*)(qrow + ks * 32 + fq * 8); }
      { const int rc = wid * 16 + fr; moba_group<true>(Kl, VTl, bq, wid, rc, true, ((qb + j * 256 + rc) * 8 + h) * 4 + 3, OP, LSE, fr, fq, D0, AQ, false); }
      { const int rc = (wid + 8) * 16 + fr; moba_group<true>(Kl, VTl, bn, wid + 8, rc, true, ((qb + j * 256 + rc) * 8 + h) * 4 + 3, OP, LSE, fr, fq, D0, AQ, false); } }
    if (wid < NGg) {
        bf16x8 bq[4]; int gi = wid;
        int idx = gi * 16 + fr; bool valid = idx < nl; unsigned e = list[valid ? idx : 0];
        { const bf16_t* qrow = AQ + (qb + (e & 0x1FFF)) * 1024 + h * 128;
#pragma unroll
          for (int ks = 0; ks < 4; ++ks) bq[ks] = *(const bf16x8*)(qrow + ks * 32 + fq * 8); }
        MobaDef D; D.val = false; D.op = OP; D.lp = LSE; D.lse = 0.f;
#pragma unroll
        for (int p = 0; p < 4; ++p) D.v[p] = (u32x4){0u, 0u, 0u, 0u};
        for (;;) {
            const int gn = gi + 8; const bool hn = gn < NGg;
            unsigned en = 0; bool vn = false;
            if (hn) { const int idn = gn * 16 + fr; vn = idn < nl; en = list[vn ? idn : 0]; }
            const bf16_t* nq = AQ + (qb + (en & 0x1FFF)) * 1024 + h * 128 + fq * 8;
            moba_group<false, true>(Kl, VTl, bq, 0, 0, valid, ((qb + (e & 0x1FFF)) * 8 + h) * 4 + (e >> 13), OP, LSE, fr, fq, D, nq, hn);
            if (!hn) break;
            e = en; valid = vn; gi = gn;
        }
        if (D.val) {
#pragma unroll
            for (int p = 0; p < 4; ++p) *(u32x4*)(D.op + p * 32) = D.v[p];
            if (fq == 0) *D.lp = D.lse; }
    }
}
__device__ __forceinline__ float logsig(float x) { return fminf(x, 0.f) - log1pf(expf(-fabsf(x))); }
__device__ void mlstm_prep_phase(const Params& P) {
    const int tid = threadIdx.x, lane = tid & 63, wid = tid >> 6;
    const bf16_t* QK = (const bf16_t*)(P.ws + WS_Z) + PL_QK * PLANE; bf16_t* QKC = (bf16_t*)(P.ws + WS_QKC);
    const int gtid = blockIdx.x * 512 + tid, gs = gridDim.x * 512;
    if ((gs & 127) == 0) {
        const int col = (gtid & 127) * 8;
        float cw[4][8], cb[8];
#pragma unroll
        for (int jt = 0; jt < 4; ++jt)
#pragma unroll
            for (int c = 0; c < 8; ++c) cw[jt][c] = P.conv_w[jt * 1024 + col + c];
#pragma unroll
        for (int c = 0; c < 8; ++c) cb[c] = P.conv_b[col + c];
        const float oscale = (col >= 512) ? 0.08838834764831845f : 1.0f;
        for (int task = gtid; task < (T_ / 4) * 128; task += gs) {
            const int row0 = (task >> 7) * 4, tin = row0 & (SEQ_ - 1);
            float xr[7][8];
#pragma unroll
            for (int r = 0; r < 7; ++r) { u32x4 w = (u32x4){0u, 0u, 0u, 0u};
                if (tin - 3 + r >= 0) w = *(const u32x4*)(QK + (size_t)(row0 - 3 + r) * 1024 + col);
                xr[r][0] = bf_lo(w.x); xr[r][1] = bf_hi(w.x); xr[r][2] = bf_lo(w.y); xr[r][3] = bf_hi(w.y); xr[r][4] = bf_lo(w.z); xr[r][5] = bf_hi(w.z); xr[r][6] = bf_lo(w.w); xr[r][7] = bf_hi(w.w); }
#pragma unroll
            for (int i = 0; i < 4; ++i) { float y[8];
#pragma unroll
                for (int c = 0; c < 8; ++c) { const float s = cb[c] + cw[0][c] * xr[i][c] + cw[1][c] * xr[i + 1][c] + cw[2][c] * xr[i + 2][c] + cw[3][c] * xr[i + 3][c]; y[c] = s * sigm(s) * oscale; }
                u32x4 w; w.x = cvt_pk_bf16(y[0], y[1]); w.y = cvt_pk_bf16(y[2], y[3]); w.z = cvt_pk_bf16(y[4], y[5]); w.w = cvt_pk_bf16(y[6], y[7]);
                *(u32x4*)(QKC + (size_t)(row0 + i) * 1024 + col) = w; }
        }
    }
    const float* IF = (const float*)(P.ws + WS_IF); float* GB = (float*)(P.ws + WS_GB); float* GU = (float*)(P.ws + WS_GU); float* GCM = (float*)(P.ws + WS_GCM);
    for (int wt = blockIdx.x * 8 + wid; wt < 16 * 128; wt += gridDim.x * 8) { const int bh = wt >> 7, n = wt & 127, b = bh >> 2, h = bh & 3;
        const size_t row = (size_t)b * SEQ_ + n * 64 + lane;
        const float ig = IF[row * 8 + h], fp = IF[row * 8 + 4 + h];
        float bs = logsig(fp);
#pragma unroll
        for (int d = 1; d < 64; d <<= 1) { const float t = __shfl_up(bs, d); if (lane >= d) bs += t; }
        const float u = ig - bs; float cm = u;
#pragma unroll
        for (int d = 1; d < 64; d <<= 1) { const float t = __shfl_up(cm, d); if (lane >= d) cm = fmaxf(cm, t); }
        const size_t o = (size_t)bh * SEQ_ + n * 64 + lane; GB[o] = bs; GU[o] = u; GCM[o] = cm; }
}
template <bool FULL> __device__ void mlstm_seg(const Params& P, int unit, unsigned char* lds) {
    const int tid = opaque_tid(), lane = tid & 63, wid = tid >> 6, fr = lane & 15, fq = lane >> 4;
    const int bh = unit >> 4, seg = unit & 15, b = bh >> 2, h = bh & 3;
    bf16_t* Qs = (bf16_t*)lds;
    bf16_t* Ks = Qs + 64 * 136;
    bf16_t* KsT = Ks + 64 * 136;
    bf16_t* KWT = KsT + 128 * 72;
    bf16_t* VT = KWT + 128 * 72;
    bf16_t* Ps = VT + 256 * 72;
    float* FL = (float*)(Ps + 64 * 72);
    float* NV = FL + 512;
    const bf16_t* QKC = (const bf16_t*)(P.ws + WS_QKC); const bf16_t* MV = (const bf16_t*)(P.ws + WS_Z) + PL_MV * PLANE;
    const float* GB = (const float*)(P.ws + WS_GB) + (size_t)bh * SEQ_; const float* GU = (const float*)(P.ws + WS_GU) + (size_t)bh * SEQ_; const float* GCM = (const float*)(P.ws + WS_GCM) + (size_t)bh * SEQ_;
    bf16_t* HU = (bf16_t*)(P.ws + WS_HU); float* LG = (float*)(P.ws + WS_LG); const float* CI = (const float*)(P.ws + WS_CI); float* LDp = (float*)(P.ws + WS_LD);
    __syncthreads();
    const int n0 = seg * 8;
    float m_prev = 0.f, dprod = 1.f;
    if (wid == 0) {
#pragma unroll
        for (int rnd = 0; rnd < 2; ++rnd) { const int n = rnd * 64 + lane; float a = 0.f, bb = -INFINITY;
            if (n < n0) { const float g = GB[n * 64 + 63], c = GCM[n * 64 + 63]; a = g; bb = c + g; }
#pragma unroll
            for (int d = 1; d < 64; d <<= 1) { const float ta = __shfl_up(a, d), tb = __shfl_up(bb, d); if (lane >= d) { bb = fmaxf(tb + a, bb); a = ta + a; } }
            const float A = __shfl(a, 63), B = __shfl(bb, 63); m_prev = fmaxf(m_prev + A, B); }
    }
    const int cs0 = wid, cs1 = wid + 8;
    f32x4 Cacc[8][2];
#pragma unroll
    for (int dt = 0; dt < 8; ++dt)
#pragma unroll
        for (int s = 0; s < 2; ++s) { Cacc[dt][s] = (f32x4){0.f, 0.f, 0.f, 0.f};
            if (FULL) { const int c = (s == 0 ? cs0 : cs1) * 16 + fr;
                Cacc[dt][s] = *(const f32x4*)(CI + ((size_t)unit * 272 + c) * 128 + dt * 16 + fq * 4); } }
    float nreg = 0.f;
    if (tid < 128) { if (FULL) nreg = CI[((size_t)unit * 272 + 256) * 128 + tid]; NV[tid] = nreg; }
    const int cgI = tid & 31, rg = tid >> 5, isK = cgI >> 4, chl = (cgI & 15) * 8, col = isK * 512 + h * 128 + chl, l0 = rg * 4;
    const int vg = tid & 31, tg = tid >> 5;
    const size_t seqb = (size_t)b * SEQ_;
#pragma unroll 1
    for (int k = 0; k < 8; ++k) {
        const int n = n0 + k; const size_t rowb = seqb + (size_t)n * 64;
        if (FULL || isK) { u32x4 rq[4];
#pragma unroll
            for (int i = 0; i < 4; ++i) rq[i] = *(const u32x4*)(QKC + (rowb + l0 + i) * 1024 + col);
            bf16_t* dst = isK ? Ks : Qs;
#pragma unroll
            for (int i = 0; i < 4; ++i) *(u32x4*)(dst + (l0 + i) * 136 + chl) = rq[i];
            if (isK) { const unsigned q0[4] = {rq[0].x, rq[0].y, rq[0].z, rq[0].w}, q1[4] = {rq[1].x, rq[1].y, rq[1].z, rq[1].w}, q2[4] = {rq[2].x, rq[2].y, rq[2].z, rq[2].w}, q3[4] = {rq[3].x, rq[3].y, rq[3].z, rq[3].w};
#pragma unroll
                for (int c2 = 0; c2 < 4; ++c2) { u32x2 wl, wh;
                    wl.x = (q0[c2] & 0xffffu) | (q1[c2] << 16); wl.y = (q2[c2] & 0xffffu) | (q3[c2] << 16);
                    wh.x = (q0[c2] >> 16) | (q1[c2] & 0xffff0000u); wh.y = (q2[c2] >> 16) | (q3[c2] & 0xffff0000u);
                    *(u32x2*)(KsT + (chl + 2 * c2) * 72 + l0) = wl; *(u32x2*)(KsT + (chl + 2 * c2 + 1) * 72 + l0) = wh; } } }
        { u32x4 rv[4];
#pragma unroll
          for (int i = 0; i < 4; ++i) rv[i] = *(const u32x4*)(MV + (rowb + tg * 4 + i) * 1024 + h * 256 + vg * 8);
          const unsigned q0[4] = {rv[0].x, rv[0].y, rv[0].z, rv[0].w}, q1[4] = {rv[1].x, rv[1].y, rv[1].z, rv[1].w}, q2[4] = {rv[2].x, rv[2].y, rv[2].z, rv[2].w}, q3[4] = {rv[3].x, rv[3].y, rv[3].z, rv[3].w};
#pragma unroll
          for (int c2 = 0; c2 < 4; ++c2) { u32x2 wl, wh;
              wl.x = (q0[c2] & 0xffffu) | (q1[c2] << 16); wl.y = (q2[c2] & 0xffffu) | (q3[c2] << 16);
              wh.x = (q0[c2] >> 16) | (q1[c2] & 0xffff0000u); wh.y = (q2[c2] >> 16) | (q3[c2] & 0xffff0000u);
              *(u32x2*)(VT + (vg * 8 + 2 * c2) * 72 + tg * 4) = wl; *(u32x2*)(VT + (vg * 8 + 2 * c2 + 1) * 72 + tg * 4) = wh; } }
        if (wid == 0) { const float gb = GB[n * 64 + lane], gu = GU[n * 64 + lane], gcm = GCM[n * 64 + lane];
            const float Mx = fmaxf(m_prev, gcm), ei = __expf(m_prev - Mx); const float Mtot = __shfl(Mx, 63), g_ = __shfl(gb, 63);
            FL[lane] = gu; FL[64 + lane] = Mx; FL[128 + lane] = ei; FL[192 + lane] = __expf(gu - Mtot); FL[256 + lane] = __expf(-(gb + Mx));
            const float dec = __expf(m_prev - Mtot); if (lane == 0) FL[384] = dec; dprod *= dec; m_prev = g_ + Mtot; }
        LBAR();
        { const int idx = tid * 16, d = idx >> 6, s0 = idx & 63; const u32x4 a = *(const u32x4*)(KsT + d * 72 + s0), c = *(const u32x4*)(KsT + d * 72 + s0 + 8);
          const float4 w0 = *(const float4*)(FL + 192 + s0), w1 = *(const float4*)(FL + 192 + s0 + 4), w2 = *(const float4*)(FL + 192 + s0 + 8), w3 = *(const float4*)(FL + 192 + s0 + 12);
          u32x4 oa, oc; oa.x = cvt_pk_bf16(bf_lo(a.x) * w0.x, bf_hi(a.x) * w0.y); oa.y = cvt_pk_bf16(bf_lo(a.y) * w0.z, bf_hi(a.y) * w0.w); oa.z = cvt_pk_bf16(bf_lo(a.z) * w1.x, bf_hi(a.z) * w1.y); oa.w = cvt_pk_bf16(bf_lo(a.w) * w1.z, bf_hi(a.w) * w1.w);
          oc.x = cvt_pk_bf16(bf_lo(c.x) * w2.x, bf_hi(c.x) * w2.y); oc.y = cvt_pk_bf16(bf_lo(c.y) * w2.z, bf_hi(c.y) * w2.w); oc.z = cvt_pk_bf16(bf_lo(c.z) * w3.x, bf_hi(c.z) * w3.y); oc.w = cvt_pk_bf16(bf_lo(c.w) * w3.z, bf_hi(c.w) * w3.w);
          *(u32x4*)(KWT + d * 72 + s0) = oa; *(u32x4*)(KWT + d * 72 + s0 + 8) = oc; }
        if (FULL) {
#pragma unroll
            for (int x = 0; x < 2; ++x) { const int tile = 2 * wid + x, ti = tile >> 2, si = tile & 3;
                f32x4 a4 = (f32x4){0.f, 0.f, 0.f, 0.f};
                if (si <= ti) {
#pragma unroll
                    for (int ks = 0; ks < 4; ++ks) { const bf16x8 a = *(const bf16x8*)(Qs + (ti * 16 + fr) * 136 + ks * 32 + fq * 8); const bf16x8 bb2 = *(const bf16x8*)(Ks + (si * 16 + fr) * 136 + ks * 32 + fq * 8);
                        a4 = __builtin_amdgcn_mfma_f32_16x16x32_bf16(a, bb2, a4, 0, 0, 0); } }
                const int s = si * 16 + fr; const float us = FL[s]; const float4 mx4 = *(const float4*)(FL + 64 + ti * 16 + fq * 4); const float mxa[4] = {mx4.x, mx4.y, mx4.z, mx4.w};
#pragma unroll
                for (int jj = 0; jj < 4; ++jj) { const int t = ti * 16 + fq * 4 + jj; const float e = __expf(us - mxa[jj]); const float pv = (s <= t) ? a4[jj] * e : 0.f;
                    Ps[t * 72 + s] = (bf16_t)(cvt_pk_bf16(pv, 0.f) & 0xffff); } } }
        LBAR();
        const float decay = FL[384];
        u32x4 Cb[2][4];
        if (FULL) {
#pragma unroll
            for (int s = 0; s < 2; ++s)
#pragma unroll
                for (int q = 0; q < 4; ++q) { Cb[s][q].x = cvt_pk_bf16(Cacc[2 * q][s][0], Cacc[2 * q][s][1]); Cb[s][q].y = cvt_pk_bf16(Cacc[2 * q][s][2], Cacc[2 * q][s][3]);
                    Cb[s][q].z = cvt_pk_bf16(Cacc[2 * q + 1][s][0], Cacc[2 * q + 1][s][1]); Cb[s][q].w = cvt_pk_bf16(Cacc[2 * q + 1][s][2], Cacc[2 * q + 1][s][3]); } }
        bf16x8 VTb[2][2];
#pragma unroll
        for (int ks = 0; ks < 2; ++ks) { VTb[0][ks] = *(const bf16x8*)(VT + (cs0 * 16 + fr) * 72 + ks * 32 + fq * 8); VTb[1][ks] = *(const bf16x8*)(VT + (cs1 * 16 + fr) * 72 + ks * 32 + fq * 8); }
        { const float* nv_old = NV + (k & 1) * 128; float* nv_new = NV + ((k + 1) & 1) * 128;
          if (FULL) {
              const int t_ = tid >> 3, part = tid & 7;
              const u32x4 qa = *(const u32x4*)(Qs + t_ * 136 + part * 16), qb = *(const u32x4*)(Qs + t_ * 136 + part * 16 + 8);
              const float4 n0v = *(const float4*)(nv_old + part * 16), n1v = *(const float4*)(nv_old + part * 16 + 4), n2v = *(const float4*)(nv_old + part * 16 + 8), n3v = *(const float4*)(nv_old + part * 16 + 12);
              float qn = bf_lo(qa.x) * n0v.x + bf_hi(qa.x) * n0v.y + bf_lo(qa.y) * n0v.z + bf_hi(qa.y) * n0v.w + bf_lo(qa.z) * n1v.x + bf_hi(qa.z) * n1v.y + bf_lo(qa.w) * n1v.z + bf_hi(qa.w) * n1v.w
                       + bf_lo(qb.x) * n2v.x + bf_hi(qb.x) * n2v.y + bf_lo(qb.y) * n2v.z + bf_hi(qb.y) * n2v.w + bf_lo(qb.z) * n3v.x + bf_hi(qb.z) * n3v.y + bf_lo(qb.w) * n3v.z + bf_hi(qb.w) * n3v.w;
              const u32x4 pr = *(const u32x4*)(Ps + t_ * 72 + part * 8);
              const float rs = bf_lo(pr.x) + bf_hi(pr.x) + bf_lo(pr.y) + bf_hi(pr.y) + bf_lo(pr.z) + bf_hi(pr.z) + bf_lo(pr.w) + bf_hi(pr.w);
              float v = FL[128 + t_] * qn + rs;
              v += __shfl_xor(v, 1); v += __shfl_xor(v, 2); v += __shfl_xor(v, 4);
              if (part == 0) FL[320 + t_] = v; }
          if (tid < 128) {
              float acc = 0.f;
#pragma unroll
              for (int i = 0; i < 8; ++i) { const u32x4 kw = *(const u32x4*)(KWT + tid * 72 + i * 8);
                  acc += bf_lo(kw.x) + bf_hi(kw.x) + bf_lo(kw.y) + bf_hi(kw.y) + bf_lo(kw.z) + bf_hi(kw.z) + bf_lo(kw.w) + bf_hi(kw.w); }
              nreg = nreg * decay + acc; nv_new[tid] = nreg; } }
#pragma unroll
        for (int dt = 0; dt < 8; ++dt) { const bf16x8 a0 = *(const bf16x8*)(KWT + (dt * 16 + fr) * 72 + fq * 8), a1 = *(const bf16x8*)(KWT + (dt * 16 + fr) * 72 + 32 + fq * 8);
#pragma unroll
            for (int s = 0; s < 2; ++s) {
                f32x4 c = Cacc[dt][s] * decay; c = __builtin_amdgcn_mfma_f32_16x16x32_bf16(a0, VTb[s][0], c, 0, 0, 0); c = __builtin_amdgcn_mfma_f32_16x16x32_bf16(a1, VTb[s][1], c, 0, 0, 0); Cacc[dt][s] = c; } }
        LBAR();
        if (FULL) {
#pragma unroll 1
            for (int ti = 0; ti < 4; ++ti) {
                u32x4 aq[4];
#pragma unroll
                for (int q = 0; q < 4; ++q) { const bf16_t* qp = Qs + (ti * 16 + fr) * 136 + q * 32 + fq * 4; const u32x2 a0 = *(const u32x2*)qp, a1 = *(const u32x2*)(qp + 16); aq[q].x = a0.x; aq[q].y = a0.y; aq[q].z = a1.x; aq[q].w = a1.y; }
                const bf16x8 ap0 = *(const bf16x8*)(Ps + (ti * 16 + fr) * 72 + fq * 8), ap1 = *(const bf16x8*)(Ps + (ti * 16 + fr) * 72 + 32 + fq * 8);
                const float4 e4 = *(const float4*)(FL + 128 + ti * 16 + fq * 4), d4 = *(const float4*)(FL + 320 + ti * 16 + fq * 4), b4 = *(const float4*)(FL + 256 + ti * 16 + fq * 4);
                const float rd[4] = {__builtin_amdgcn_rcpf(fmaxf(fabsf(d4.x), b4.x)), __builtin_amdgcn_rcpf(fmaxf(fabsf(d4.y), b4.y)), __builtin_amdgcn_rcpf(fmaxf(fabsf(d4.z), b4.z)), __builtin_amdgcn_rcpf(fmaxf(fabsf(d4.w), b4.w))};
#pragma unroll
                for (int s = 0; s < 2; ++s) { f32x4 nacc = (f32x4){0.f, 0.f, 0.f, 0.f};
#pragma unroll
                    for (int q = 0; q < 4; ++q) nacc = __builtin_amdgcn_mfma_f32_16x16x32_bf16(__builtin_bit_cast(bf16x8, aq[q]), __builtin_bit_cast(bf16x8, Cb[s][q]), nacc, 0, 0, 0);
                    nacc[0] *= e4.x; nacc[1] *= e4.y; nacc[2] *= e4.z; nacc[3] *= e4.w;
                    nacc = __builtin_amdgcn_mfma_f32_16x16x32_bf16(ap0, VTb[s][0], nacc, 0, 0, 0); nacc = __builtin_amdgcn_mfma_f32_16x16x32_bf16(ap1, VTb[s][1], nacc, 0, 0, 0);
                    bf16_t* hp = HU + (rowb + ti * 16 + fq * 4) * 1024 + h * 256 + (s == 0 ? cs0 : cs1) * 16 + fr;
#pragma unroll
                    for (int jj = 0; jj < 4; ++jj) hp[jj * 1024] = (bf16_t)(cvt_pk_bf16(nacc[jj] * rd[jj], 0.f) & 0xffff); } }
            LBAR();
        }
    }
    if (!FULL) {
#pragma unroll
        for (int dt = 0; dt < 8; ++dt)
#pragma unroll
            for (int s = 0; s < 2; ++s) { const int c = (s == 0 ? cs0 : cs1) * 16 + fr;
                *(f32x4*)(LG + ((size_t)unit * 272 + c) * 128 + dt * 16 + fq * 4) = Cacc[dt][s]; }
        if (tid < 128) LG[((size_t)unit * 272 + 256) * 128 + tid] = nreg;
        if (tid == 0) LDp[unit] = dprod;
    }
}
__device__ void mlstm_pass2(const Params& P) {
    const float* LG = (const float*)(P.ws + WS_LG); float* CI = (float*)(P.ws + WS_CI); const float* LDp = (const float*)(P.ws + WS_LD);
    const int gtid = blockIdx.x * 512 + opaque_tid(), gs = gridDim.x * 512;
    for (int task = gtid; task < 16 * 257 * 32; task += gs) { const int d4 = task & 31, c = (task >> 5) % 257, bh = task / (257 * 32);
        f32x4 L[16]; float D[16];
#pragma unroll
        for (int g = 0; g < 16; ++g) { L[g] = *(const f32x4*)(LG + ((size_t)(bh * 16 + g) * 272 + c) * 128 + d4 * 4); D[g] = LDp[bh * 16 + g]; }
        f32x4 C = (f32x4){0.f, 0.f, 0.f, 0.f};
#pragma unroll
        for (int g = 0; g < 16; ++g) { *(f32x4*)(CI + ((size_t)(bh * 16 + g) * 272 + c) * 128 + d4 * 4) = C; C = C * D[g] + L[g]; }
    }
}
__device__ void finalize_phase(const Params& P) {
    const int tid = threadIdx.x, lane = tid & 63, wid = tid >> 6;
    const bf16_t* HU = (const bf16_t*)(P.ws + WS_HU); const bf16_t* MO = (const bf16_t*)(P.ws + WS_Z) + PL_MO * PLANE; bf16_t* HM = (bf16_t*)(P.ws + WS_HM);
    const float* LSE = (const float*)(P.ws + WS_LSE); const bf16_t* OP = (const bf16_t*)P.out; bf16_t* HA = (bf16_t*)(P.ws + WS_HA);
    float gn[16];
#pragma unroll
    for (int e = 0; e < 16; ++e) gn[e] = P.m_out_norm[lane * 16 + e];
    for (int row = blockIdx.x * 8 + wid; row < T_; row += gridDim.x * 8) {
        const int hd = lane >> 3, d0 = (lane & 7) * 16; const size_t ro = ((size_t)row * 8 + hd) * 4;
        const float4 ls = *(const float4*)(LSE + ro);
        u32x4 pa[4], pq[4];
#pragma unroll
        for (int s = 0; s < 4; ++s) { const bf16_t* op = OP + (ro + s) * 128 + d0; pa[s] = *(const u32x4*)op; pq[s] = *(const u32x4*)(op + 8); }
        { const size_t off = (size_t)row * 1024 + lane * 16;
          const u32x4 a = *(const u32x4*)(HU + off), bq = *(const u32x4*)(HU + off + 8); const u32x4 ma = *(const u32x4*)(MO + off), mb = *(const u32x4*)(MO + off + 8);
          float v[16] = {bf_lo(a.x), bf_hi(a.x), bf_lo(a.y), bf_hi(a.y), bf_lo(a.z), bf_hi(a.z), bf_lo(a.w), bf_hi(a.w), bf_lo(bq.x), bf_hi(bq.x), bf_lo(bq.y), bf_hi(bq.y), bf_lo(bq.z), bf_hi(bq.z), bf_lo(bq.w), bf_hi(bq.w)};
          const float mo[16] = {bf_lo(ma.x), bf_hi(ma.x), bf_lo(ma.y), bf_hi(ma.y), bf_lo(ma.z), bf_hi(ma.z), bf_lo(ma.w), bf_hi(ma.w), bf_lo(mb.x), bf_hi(mb.x), bf_lo(mb.y), bf_hi(mb.y), bf_lo(mb.z), bf_hi(mb.z), bf_lo(mb.w), bf_hi(mb.w)};
          float ss = 0.f;
#pragma unroll
          for (int e = 0; e < 16; ++e) ss += v[e] * v[e];
          ss += __shfl_xor(ss, 1); ss += __shfl_xor(ss, 2); ss += __shfl_xor(ss, 4); ss += __shfl_xor(ss, 8);
          const float rinv = rsqrtf(ss * (1.0f / 256.0f) + EPS_);
#pragma unroll
          for (int e = 0; e < 16; ++e) v[e] = v[e] * rinv * gn[e] * sigm(mo[e]);
          u32x4 o0, o1; o0.x = cvt_pk_bf16(v[0], v[1]); o0.y = cvt_pk_bf16(v[2], v[3]); o0.z = cvt_pk_bf16(v[4], v[5]); o0.w = cvt_pk_bf16(v[6], v[7]);
          o1.x = cvt_pk_bf16(v[8], v[9]); o1.y = cvt_pk_bf16(v[10], v[11]); o1.z = cvt_pk_bf16(v[12], v[13]); o1.w = cvt_pk_bf16(v[14], v[15]);
          *(u32x4*)(HM + off) = o0; *(u32x4*)(HM + off + 8) = o1; }
        { const int cblk = (row & (SEQ_ - 1)) >> 8; const int nv = cblk < 3 ? cblk : 3;
          const float l0 = nv > 0 ? ls.x : -INFINITY, l1 = nv > 1 ? ls.y : -INFINITY, l2 = nv > 2 ? ls.z : -INFINITY, l3 = ls.w;
          const float M = fmaxf(fmaxf(l0, l1), fmaxf(l2, l3));
          float w[4] = {nv > 0 ? __builtin_amdgcn_exp2f(l0 - M) : 0.f, nv > 1 ? __builtin_amdgcn_exp2f(l1 - M) : 0.f, nv > 2 ? __builtin_amdgcn_exp2f(l2 - M) : 0.f, __builtin_amdgcn_exp2f(l3 - M)};
          const float inv = 1.0f / (w[0] + w[1] + w[2] + w[3]);
          float acc[16];
#pragma unroll
          for (int e = 0; e < 16; ++e) acc[e] = 0.f;
#pragma unroll
          for (int s = 0; s < 4; ++s) { if (s < 3 && s >= nv) continue; const u32x4 a = pa[s], bq = pq[s]; const float ws_ = w[s] * inv;
              acc[0] += ws_ * bf_lo(a.x); acc[1] += ws_ * bf_hi(a.x); acc[2] += ws_ * bf_lo(a.y); acc[3] += ws_ * bf_hi(a.y); acc[4] += ws_ * bf_lo(a.z); acc[5] += ws_ * bf_hi(a.z); acc[6] += ws_ * bf_lo(a.w); acc[7] += ws_ * bf_hi(a.w);
              acc[8] += ws_ * bf_lo(bq.x); acc[9] += ws_ * bf_hi(bq.x); acc[10] += ws_ * bf_lo(bq.y); acc[11] += ws_ * bf_hi(bq.y); acc[12] += ws_ * bf_lo(bq.z); acc[13] += ws_ * bf_hi(bq.z); acc[14] += ws_ * bf_lo(bq.w); acc[15] += ws_ * bf_hi(bq.w); }
          u32x4 o0, o1; o0.x = cvt_pk_bf16(acc[0], acc[1]); o0.y = cvt_pk_bf16(acc[2], acc[3]); o0.z = cvt_pk_bf16(acc[4], acc[5]); o0.w = cvt_pk_bf16(acc[6], acc[7]);
          o1.x = cvt_pk_bf16(acc[8], acc[9]); o1.y = cvt_pk_bf16(acc[10], acc[11]); o1.z = cvt_pk_bf16(acc[12], acc[13]); o1.w = cvt_pk_bf16(acc[14], acc[15]);
          bf16_t* hp = HA + (size_t)row * 1024 + hd * 128 + d0; *(u32x4*)hp = o0; *(u32x4*)(hp + 8) = o1; }
    }
}

template <class Epi> __device__ __forceinline__ void run_gemm(unsigned char* lds, const bf16_t* A, const bf16_t* Bt, int N, int K, const Epi& E) {
    pg8::Gemm g; g.A = A; g.Bt = Bt; g.M = T_; g.N = N; g.K = K;
    pg8::StaticOrder S; S.init(T_, N, (int)gridDim.x, (int)blockIdx.x);
    pg8::gemm_phase<Epi, pg8::StaticOrder, true, true>((PG8_LAS unsigned char*)lds, g, S, E);
    __syncthreads();
}

#define LAS __attribute__((address_space(3)))
#define XB_TMO      128
#define XB_XCNT(j)  (256  + 64 * (j))
#define XB_XSUB(j)  (1280 + 64 * (j))
#define XB_XGEN(j)  (2304 + 64 * (j))
#define XB_TOP      3328
#define XB_TOPGEN   3392
#define XCD_BAR_WORDS 3456
#define XB_SPIN_CAP (1u << 18)

__device__ __forceinline__ unsigned xb_ld(unsigned* p)              { return __hip_atomic_load(p, __ATOMIC_RELAXED, __HIP_MEMORY_SCOPE_AGENT); }
__device__ __forceinline__ unsigned xb_add(unsigned* p, unsigned v) { return __hip_atomic_fetch_add(p, v, __ATOMIC_RELAXED, __HIP_MEMORY_SCOPE_AGENT); }
__device__ __forceinline__ unsigned xb_xcc_id() { return (unsigned)__builtin_amdgcn_s_getreg((3 << 11) | 20) & 0xFu; }
#define XB_SPIN(cond, bar) do { unsigned _sp = 0; while (cond) { __builtin_amdgcn_s_sleep(1); \
    if ((++_sp & 255u) == 0u) { if (xb_ld(&(bar)[XB_TMO])) break; if (_sp > XB_SPIN_CAP) { atomicAdd(&(bar)[XB_TMO], 1u); break; } } } } while (0)

struct XcdBarrier {
    unsigned* bar; unsigned x;
    volatile LAS unsigned* st;
};

__device__ __forceinline__ XcdBarrier xcd_barrier_post(unsigned* bar, volatile LAS unsigned* st) {
    XcdBarrier b; b.bar = bar; b.x = xb_xcc_id(); b.st = st;
    if (threadIdx.x == 0) (void)xb_add(&bar[XB_XCNT(b.x)], 1u);
    return b;
}
__device__ __forceinline__ void xcd_barrier_complete(unsigned* bar, unsigned x, unsigned& nloc, unsigned& nx) {
    const unsigned G = gridDim.x * gridDim.y * gridDim.z;
    unsigned sum, cnt, mine, sp = 0u;
    for (;;) {
        sum = 0u; cnt = 0u; mine = 0u;
#pragma unroll
        for (unsigned j = 0; j < 16; ++j) { const unsigned c = xb_ld(&bar[XB_XCNT(j)]); sum += c; cnt += (c > 0u) ? 1u : 0u; mine = (j == x) ? c : mine; }
        if (sum == G) break;
        __builtin_amdgcn_s_sleep(1);
        if ((++sp & 255u) == 0u) { if (xb_ld(&bar[XB_TMO])) break; if (sp > XB_SPIN_CAP) { atomicAdd(&bar[XB_TMO], 1u); break; } }
    }
    nloc = mine > 0u ? mine : 1u; nx = cnt > 0u ? cnt : 1u;
}

__device__ __forceinline__ void xcd_barrier(const XcdBarrier& b) {
    asm volatile("s_waitcnt vmcnt(0)" ::: "memory");
    __syncthreads();
    if (threadIdx.x == 0) {
        unsigned* bar = b.bar;
        __builtin_amdgcn_s_waitcnt(0);
        unsigned nloc = b.st[0], nx = b.st[1];
        if (nloc == 0u) { xcd_barrier_complete(bar, b.x, nloc, nx); b.st[0] = nloc; b.st[1] = nx; }
        const unsigned old = xb_add(&bar[XB_XSUB(b.x)], 1u);
        const unsigned gen = old / nloc;
        if (old + 1u == (gen + 1u) * nloc) {
            __builtin_amdgcn_fence(__ATOMIC_RELEASE, "agent");
            asm volatile("s_waitcnt vmcnt(0)" ::: "memory");
            const unsigned og = xb_add(&bar[XB_TOP], 1u);
            const unsigned tg = og / nx;
            if (og + 1u == (tg + 1u) * nx) xb_add(&bar[XB_TOPGEN], 1u);
            else XB_SPIN(xb_ld(&bar[XB_TOPGEN]) == tg, bar);
            __builtin_amdgcn_fence(__ATOMIC_ACQUIRE, "agent");
            xb_add(&bar[XB_XGEN(b.x)], 1u);
            asm volatile("s_waitcnt vmcnt(0)" ::: "memory");
        } else {
            XB_SPIN(xb_ld(&bar[XB_XGEN(b.x)]) == gen, bar);
            __builtin_amdgcn_fence(__ATOMIC_ACQUIRE, "agent");
            asm volatile("s_waitcnt vmcnt(0)" ::: "memory");
        }
    }
    __syncthreads();
}


__global__ void __launch_bounds__(512, 2) mega_fwd(Params P) {
    extern __shared__ __attribute__((aligned(16))) unsigned char lds[];
    cg::grid_group grid = cg::this_grid();
    unsigned char* ws = P.ws;
    bf16_t* Z = (bf16_t*)(ws + WS_Z);
    volatile LAS unsigned* xst = (volatile LAS unsigned*)((LAS unsigned char*)lds + (LDS_BYTES - 64));
    if (threadIdx.x < 4) xst[threadIdx.x] = 0u;
    __syncthreads();
    const XcdBarrier xbar = xcd_barrier_post((unsigned*)(ws + WS_XBAR), xst);
    weights_phase(P, lds);
    rms_phase<0>(P.x, P.attn_norm, (bf16_t*)(ws + WS_XN), nullptr, P, lds);
    misc_prologue(P);
    xcd_barrier(xbar);
    if (gridDim.x == 0x7fffffffu) grid.sync();
    { pg8::EpiB<pg8::EM_Z> E{}; E.O = Z; E.ldc = 1024; E.aux1 = nullptr; E.aux2 = nullptr; E.plane = PLANE;
      run_gemm(lds, (const bf16_t*)(ws + WS_XN), (const bf16_t*)(ws + WS_WIN), NZ, 2048, E); }
    xcd_barrier(xbar);
    moba_prep_phase(P, lds);
    mlstm_prep_phase(P);
    xcd_barrier(xbar);
    for (int u = blockIdx.x; u < 256; u += gridDim.x) mlstm_seg<false>(P, u, lds);
    moba_route_phase(P, lds);
    xcd_barrier(xbar);
    mlstm_pass2(P);
    xcd_barrier(xbar);
    for (int u = blockIdx.x; u < 256; u += gridDim.x) mlstm_seg<true>(P, u, lds);
    { const int G = gridDim.x;
      const int grp = (int)blockIdx.x >> 5;
      const unsigned pk = grp == 0 ? (0u | (21u << 5) | (28u << 10) | (29u << 15)) : grp == 1 ? (1u | (18u << 5) | (22u << 10) | (31u << 15)) : grp == 2 ? (2u | (14u << 5) | (24u << 10) | (25u << 15))
                        : grp == 3 ? (3u | (12u << 5) | (17u << 10) | (30u << 15)) : grp == 4 ? (4u | (11u << 5) | (16u << 10) | (26u << 15)) : grp == 5 ? (5u | (10u << 5) | (19u << 10) | (20u << 15))
                        : grp == 6 ? (6u | (9u << 5) | (13u << 10) | (27u << 15)) : (7u | (8u << 5) | (15u << 10) | (23u << 15));
      for (int it = 0; it * G < 1024; ++it) { int j, bh;
          if (G == 256) { j = (int)((pk >> (5 * it)) & 31u); bh = (int)blockIdx.x & 31; }
          else { const int pos = (it & 1) ? (G - 1 - (int)blockIdx.x) : (int)blockIdx.x; const int u = it * G + pos; if (u >= 1024) continue; j = u >> 5; bh = u & 31; }
          moba_unit(P, bh >> 3, bh & 7, j, lds); } }
    xcd_barrier(xbar);
    finalize_phase(P);
    xcd_barrier(xbar);
    { pg8::EpiB<pg8::EM_TMP> E{}; E.O = (bf16_t*)(ws + WS_TMP); E.ldc = 2048; E.aux1 = Z + PL_GM * PLANE; E.aux2 = nullptr; E.plane = PLANE;
      run_gemm(lds, (const bf16_t*)(ws + WS_HM), (const bf16_t*)(ws + WS_WM), 2048, 1024, E); }
    __threadfence();
    { pg8::EpiB<pg8::EM_MG> E{}; E.O = (bf16_t*)(ws + WS_MG); E.ldc = 2048; E.aux1 = Z + PL_GA * PLANE; E.aux2 = (const bf16_t*)(ws + WS_TMP); E.plane = PLANE;
      run_gemm(lds, (const bf16_t*)(ws + WS_HA), (const bf16_t*)(ws + WS_WA), 2048, 1024, E); }
    xcd_barrier(xbar);
    { pg8::EpiF<pg8::EF_RES, true, false, true> E{}; E.Ob = (bf16_t*)(ws + WS_X1B); E.res = P.x; E.pp = nullptr; E.ldc = 2048; E.hb = (bf16_t*)(ws + WS_XN); E.gvec = P.mlp_norm; E.rsq = (float*)(ws + WS_RSQ1);
      run_gemm(lds, (const bf16_t*)(ws + WS_MG), (const bf16_t*)(ws + WS_WOUT), 2048, 2048, E); }
    xcd_barrier(xbar);
    { pg8::EpiB<pg8::EM_RELU2> E{}; E.O = (bf16_t*)(ws + WS_U); E.ldc = 8192; E.aux1 = nullptr; E.aux2 = nullptr; E.plane = 0;
      E.rsq_in = (const float*)(ws + WS_RSQ1);
      run_gemm(lds, (const bf16_t*)(ws + WS_XN), (const bf16_t*)(ws + WS_W1), 8192, 2048, E); }
    xcd_barrier(xbar);
    { pg8::EpiF<pg8::EF_RES, true, true, false> E{}; E.O = P.out; E.resb = (const bf16_t*)(ws + WS_X1B); E.pp = nullptr; E.ldc = 2048; E.hb = (bf16_t*)(ws + WS_XN); E.gvec = P.ple_norm; E.rsq = (float*)(ws + WS_RSQ2);
      run_gemm(lds, (const bf16_t*)(ws + WS_U), (const bf16_t*)(ws + WS_W2), 2048, 8192, E); }
    xcd_barrier(xbar);
    { pg8::EpiB<pg8::EM_PLAIN> E{}; E.O = (bf16_t*)(ws + WS_PP); E.ldc = 2048; E.aux1 = nullptr; E.aux2 = nullptr; E.plane = 0;
      run_gemm(lds, (const bf16_t*)(ws + WS_PB), (const bf16_t*)(ws + WS_WP), 2048, 256, E); }
    __threadfence(); __syncthreads();
    { pg8::EpiF<pg8::EF_PLE, false> E{}; E.O = P.out; E.res = P.out; E.pp = (const bf16_t*)(ws + WS_PP); E.ldc = 2048; E.rsq_in = (const float*)(ws + WS_RSQ2);
      run_gemm(lds, (const bf16_t*)(ws + WS_XN), (const bf16_t*)(ws + WS_WG), 2048, 2048, E); }
    xcd_barrier(xbar);
    rms_phase<2>(P.out, P.final_norm, nullptr, P.out, P, lds);
}

extern "C" void kernel_launch(void* const* d_in, const int* in_sizes, int n_in, void* d_out, int out_size, void* d_ws, size_t ws_size, hipStream_t stream) {
    static int grid_blocks = 0;
    if (grid_blocks == 0) {
        if (n_in != 19 || out_size != T_ * DM || ws_size < WS_END) { fprintf(stderr, "kernel_launch: unexpected shapes: n_in %d out %d ws %zu (need %zu)\n", n_in, out_size, ws_size, (size_t)WS_END); grid_blocks = -1; return; }
        int dev = 0, cus = 0, per_cu = 0;
        hipGetDevice(&dev); hipDeviceGetAttribute(&cus, hipDeviceAttributeMultiprocessorCount, dev);
        if (hipFuncSetAttribute((const void*)mega_fwd, hipFuncAttributeMaxDynamicSharedMemorySize, LDS_BYTES) != hipSuccess) { fprintf(stderr, "kernel_launch: hipFuncSetAttribute(%d B LDS) failed\n", LDS_BYTES); grid_blocks = -1; return; }
        if (hipOccupancyMaxActiveBlocksPerMultiprocessor(&per_cu, (const void*)mega_fwd, 512, LDS_BYTES) != hipSuccess || per_cu < 1) { fprintf(stderr, "kernel_launch: occupancy query gave %d\n", per_cu); per_cu = 1; }
        (void)hipGetLastError();
        grid_blocks = cus * per_cu;
        fprintf(stderr, "kernel_launch: grid %d (cus %d x %d)\n", grid_blocks, cus, per_cu);
    }
    if (grid_blocks < 0) return;
    Params P{};
    P.x = (const float*)d_in[0]; P.p = (const float*)d_in[1]; P.positions = (const int*)d_in[2]; P.attn_norm = (const float*)d_in[3]; P.w_in = (const float*)d_in[4];
    P.b_if = (const float*)d_in[5]; P.conv_w = (const float*)d_in[6]; P.conv_b = (const float*)d_in[7]; P.m_out_norm = (const float*)d_in[8]; P.w_up_m = (const float*)d_in[9];
    P.w_up_a = (const float*)d_in[10]; P.w_out = (const float*)d_in[11]; P.mlp_norm = (const float*)d_in[12]; P.w_ff1 = (const float*)d_in[13]; P.w_ff2 = (const float*)d_in[14];
    P.ple_norm = (const float*)d_in[15]; P.w_ple_gate = (const float*)d_in[16]; P.w_ple_proj = (const float*)d_in[17]; P.final_norm = (const float*)d_in[18];
    P.out = (float*)d_out; P.ws = (unsigned char*)d_ws;
    if (hipMemsetAsync((unsigned char*)d_ws + WS_XBAR, 0, 16384, stream) != hipSuccess) { fprintf(stderr, "kernel_launch: memset of the barrier words failed\n"); return; }
    void* args[] = {&P};
    hipError_t e = hipLaunchCooperativeKernel((const void*)mega_fwd, dim3(grid_blocks), dim3(512), args, LDS_BYTES, stream);
    if (e != hipSuccess) fprintf(stderr, "kernel_launch: cooperative launch failed: %s (grid %d)\n", hipGetErrorString(e), grid_blocks);
}
```

```cpp
#include <hip/hip_runtime.h>
#include <hip/hip_cooperative_groups.h>
#include <cstdio>
#include <cstdint>
namespace cg = cooperative_groups;
namespace pg8 {
#define PG8_LAS __attribute__((address_space(3)))
typedef unsigned short bf16_t;
typedef short bf16x8 __attribute__((ext_vector_type(8)));
typedef float f32x4 __attribute__((ext_vector_type(4)));
typedef unsigned u32x4 __attribute__((ext_vector_type(4)));
constexpr int BM = 256, BK = 64, HALF = 128, HTB = HALF * BK * 2  , STAGE_BYTES = 8 * HTB, NXCD = 8, WGM = 4;

__host__ __device__ __forceinline__ int lds_byte(int r, int c) { const int st = (r >> 4) * 2 + (c >> 5), rr = r & 15, cc = c & 31, ob = rr * 64 + cc * 2; return st * 1024 + (ob ^ (((ob >> 9) & 1) << 5)); }
__host__ __device__ __forceinline__ void stage_rc(int b, int& R, int& C) { const int st = b / 1024, sb = b % 1024, swz = sb ^ (((sb >> 9) & 1) << 5); R = (st >> 1) * 16 + swz / 64; C = (st & 1) * 32 + (swz % 64) / 2; }
__host__ __device__ __forceinline__ int perm32(int rho) { const int n = rho >> 4, i = rho & 15; return 8 * (i >> 2) + 4 * n + (i & 3); }

struct Unit { int pm, pn; };
struct Gemm { const bf16_t* A; const bf16_t* Bt; int M, N, K; };

struct StaticOrder {
    int nM, nN, nwg, G, c;
    __host__ __device__ void init(int M, int N, int G_, int c_) { nM = M / BM; nN = N / BM; nwg = nM * nN; G = G_; c = c_; }
    __host__ __device__ bool next(int i, Unit& u) const {
        const long L = (long)i * G + c; if (L >= nwg) return false;
        int wgid = (int)L; { const int q = nwg / NXCD, r = nwg % NXCD, xcd = wgid % NXCD, off = wgid / NXCD; wgid = (xcd < r ? xcd * (q + 1) : r * (q + 1) + (xcd - r) * q) + off; }
        const int nig = WGM * nN, gid = wgid / nig, fm = gid * WGM, gsz = (nM - fm) < WGM ? (nM - fm) : WGM;
        u.pm = fm + ((wgid % nig) % gsz); u.pn = (wgid % nig) / gsz; return true;
    }
    __device__ __forceinline__ void a_ready(const Unit&) const {}
    __device__ __forceinline__ void done(const Unit&) const {}
};
__device__ __forceinline__ unsigned cvt_pk_bf16(float lo, float hi) { unsigned r; asm volatile("v_cvt_pk_bf16_f32 %0, %1, %2" : "=v"(r) : "v"(lo), "v"(hi)); return r; }
__device__ __forceinline__ float bf_lo(unsigned w) { return __builtin_bit_cast(float, w << 16); }
__device__ __forceinline__ float bf_hi(unsigned w) { return __builtin_bit_cast(float, w & 0xffff0000u); }
__device__ __forceinline__ float sigm(float x) { return __builtin_amdgcn_rcpf(1.0f + __expf(-x)); }
typedef unsigned u32x2 __attribute__((ext_vector_type(2)));

enum { EM_Z = 0, EM_TMP = 1, EM_MG = 2, EM_RELU2 = 3, EM_PLAIN = 4 };
template <int MODE> struct EpiB {
    static constexpr bool PERM = true, AFTER_DRAIN = false;
    bf16_t* O; int ldc; const bf16_t* aux1; const bf16_t* aux2; size_t plane; const float* rsq_in;
    __device__ __forceinline__ void operator()(const f32x4 (&acc)[2][2][4][2], const Unit& u, int wr, int wc, int fr, int fq) const {
        const int row0 = u.pm * BM + wr * 64 + fr; int colt = u.pn * BM; bf16_t* base = O;
        if (MODE == EM_Z) { const int t = colt >> 10; base += (size_t)t * plane; colt &= 1023; }
        const int col0 = colt + wc * 32 + 8 * fq;
#pragma unroll
        for (int ai = 0; ai < 2; ++ai) {
            u32x4 gg[4][2], tt[4][2]; float rs[4];
#pragma unroll
            for (int m = 0; m < 4; ++m) { const int row = row0 + ai * HALF + m * 16;
                if (MODE == EM_RELU2) rs[m] = rsq_in[row];
#pragma unroll
                for (int bj = 0; bj < 2; ++bj) {
                    if (MODE == EM_TMP || MODE == EM_MG) { const int gc = u.pn * BM + bj * HALF + wc * 32 + 8 * fq;
                        gg[m][bj] = *(const u32x4*)(aux1 + (size_t)(gc >> 10) * plane + (size_t)row * 1024 + (gc & 1023)); }
                    if (MODE == EM_MG) tt[m][bj] = *(const u32x4*)(aux2 + (size_t)row * ldc + col0 + bj * HALF); } }
#pragma unroll
            for (int m = 0; m < 4; ++m) { const size_t ro = (size_t)(row0 + ai * HALF + m * 16) * ldc + col0;
#pragma unroll
                for (int bj = 0; bj < 2; ++bj) { f32x4 v0 = acc[ai][bj][m][0], v1 = acc[ai][bj][m][1];
                    const size_t off = ro + bj * HALF;
                    if (MODE == EM_TMP || MODE == EM_MG) { const u32x4 g = gg[m][bj];
                        float s0 = sigm(bf_lo(g.x)), s1 = sigm(bf_hi(g.x)), s2 = sigm(bf_lo(g.y)), s3 = sigm(bf_hi(g.y));
                        float s4 = sigm(bf_lo(g.z)), s5 = sigm(bf_hi(g.z)), s6 = sigm(bf_lo(g.w)), s7 = sigm(bf_hi(g.w));
                        v0 = (f32x4){v0[0] * s0, v0[1] * s1, v0[2] * s2, v0[3] * s3}; v1 = (f32x4){v1[0] * s4, v1[1] * s5, v1[2] * s6, v1[3] * s7};
                        if (MODE == EM_MG) { const u32x4 t = tt[m][bj];
                            v0 = (f32x4){v0[0] + bf_lo(t.x), v0[1] + bf_hi(t.x), v0[2] + bf_lo(t.y), v0[3] + bf_hi(t.y)};
                            v1 = (f32x4){v1[0] + bf_lo(t.z), v1[1] + bf_hi(t.z), v1[2] + bf_lo(t.w), v1[3] + bf_hi(t.w)}; }
                    }
                    if (MODE == EM_RELU2) { const float rin = rsqrtf(rs[m] * (1.0f / 2048.0f) + 1e-6f);
#pragma unroll
                        for (int j = 0; j < 4; ++j) { float a = fmaxf(v0[j], 0.f) * rin, b = fmaxf(v1[j], 0.f) * rin; v0[j] = a * a; v1[j] = b * b; } }
                    u32x4 w; w.x = cvt_pk_bf16(v0[0], v0[1]); w.y = cvt_pk_bf16(v0[2], v0[3]); w.z = cvt_pk_bf16(v1[0], v1[1]); w.w = cvt_pk_bf16(v1[2], v1[3]);
                    *(u32x4*)(base + off) = w; } } }
    }
};
enum { EF_RES = 0, EF_PLE = 1 };
template <int MODE, bool NORM, bool RESB = false, bool OUTB = false> struct EpiF {
    static constexpr bool PERM = false, AFTER_DRAIN = false;
    float* O; const float* res; const bf16_t* pp; int ldc; bf16_t* hb; const float* gvec; float* rsq; const float* rsq_in; bf16_t* Ob; const bf16_t* resb;
    __device__ __forceinline__ void operator()(const f32x4 (&acc)[2][2][4][2], const Unit& u, int wr, int wc, int fr, int fq) const {
        const int row0 = u.pm * BM + wr * 64 + fr, col0 = u.pn * BM + wc * 32 + 4 * fq;
        f32x4 gv[2][2];
        if (NORM) {
#pragma unroll
            for (int bj = 0; bj < 2; ++bj)
#pragma unroll
                for (int n = 0; n < 2; ++n) gv[bj][n] = *(const f32x4*)(gvec + col0 + bj * HALF + n * 16); }
#pragma unroll
        for (int ai = 0; ai < 2; ++ai)
#pragma unroll
            for (int mh = 0; mh < 2; ++mh) {
                f32x4 rr[2][2][2]; u32x2 qq[2][2][2]; float rin[2] = {1.f, 1.f};
#pragma unroll
                for (int mi = 0; mi < 2; ++mi) { const int row = row0 + ai * HALF + (mh * 2 + mi) * 16; const size_t ro = (size_t)row * ldc + col0;
                    if (MODE == EF_PLE) rin[mi] = rsq_in[row];
#pragma unroll
                    for (int bj = 0; bj < 2; ++bj)
#pragma unroll
                        for (int n = 0; n < 2; ++n) { const size_t off = ro + bj * HALF + n * 16;
                            if (RESB) { const u32x2 t2 = *(const u32x2*)(resb + off); rr[mi][bj][n] = (f32x4){bf_lo(t2.x), bf_hi(t2.x), bf_lo(t2.y), bf_hi(t2.y)}; }
                            else rr[mi][bj][n] = *(const f32x4*)(res + off);
                            if (MODE == EF_PLE) qq[mi][bj][n] = *(const u32x2*)(pp + off); } }
#pragma unroll
                for (int mi = 0; mi < 2; ++mi) { const int m = mh * 2 + mi; const int row = row0 + ai * HALF + m * 16; const size_t ro = (size_t)row * ldc + col0;
                    const float rn = (MODE == EF_PLE) ? rsqrtf(rin[mi] * (1.0f / 2048.0f) + 1e-6f) : 1.f;
                    float ss = 0.f;
#pragma unroll
                    for (int bj = 0; bj < 2; ++bj)
#pragma unroll
                        for (int n = 0; n < 2; ++n) { const size_t off = ro + bj * HALF + n * 16;
                            f32x4 v = acc[ai][bj][m][n];
                            if (MODE == EF_PLE) { const u32x2 q = qq[mi][bj][n];
                                v = (f32x4){sigm(v[0] * rn) * bf_lo(q.x), sigm(v[1] * rn) * bf_hi(q.x), sigm(v[2] * rn) * bf_lo(q.y), sigm(v[3] * rn) * bf_hi(q.y)}; }
                            const f32x4 o = rr[mi][bj][n] + v;
                            if (OUTB) { u32x2 wo; wo.x = cvt_pk_bf16(o[0], o[1]); wo.y = cvt_pk_bf16(o[2], o[3]); *(u32x2*)(Ob + off) = wo; }
                            else *(f32x4*)(O + off) = o;
                            if (NORM) { ss += o[0] * o[0] + o[1] * o[1] + o[2] * o[2] + o[3] * o[3];
                                const f32x4 h = o * gv[bj][n]; u32x2 w; w.x = cvt_pk_bf16(h[0], h[1]); w.y = cvt_pk_bf16(h[2], h[3]); *(u32x2*)(hb + off) = w; } }
                    if (NORM) { ss += __shfl_xor(ss, 16); ss += __shfl_xor(ss, 32); if (fq == 0) atomicAdd(rsq + row, ss); } } }
    }
};
template <class Epi, class Sched, bool ALIGN_EPI = false, bool SP2 = false>
__device__ __forceinline__ void gemm_phase(PG8_LAS unsigned char* lds, const Gemm g, const Sched& S, const Epi& E) {
    int tid_ = threadIdx.x; asm volatile("" : "+v"(tid_));
    const int tid = tid_, wid = __builtin_amdgcn_readfirstlane(tid >> 6), lane = tid & 63, wr = wid >> 2, wc = wid & 3, fr = lane & 15, fq = lane >> 4;
    int K_ = g.K; asm volatile("" : "+s"(K_)); const int K = K_, nt = K / BK;
    unsigned voffA[2], voffB[2];
#pragma unroll
    for (int i = 0; i < 2; ++i) { int R, C; stage_rc(tid * 16 + i * 8192, R, C); const int Rb = Epi::PERM ? ((R & ~31) + perm32(R & 31)) : R;
        voffA[i] = (unsigned)(R * K + C) * 2u; voffB[i] = (unsigned)(Rb * K + C) * 2u; }
    const size_t kstep = (size_t)(BK * 2);
    const size_t hstep = (size_t)HALF * K * 2;
    const size_t tstep = 2 * hstep;
    const unsigned ldsw = (unsigned)wid * 1024u;
    const int aoff = lds_byte(wr * 64 + fr, fq * 8), boff = lds_byte(wc * 32 + fr, fq * 8);
#define PG8_SA(b, h) (((b) * 2 + (h)) * HTB)
#define PG8_SB(b, h) ((4 + (b) * 2 + (h)) * HTB)
#define PG8_STAGE(bufoff, gbase, voff) do { _Pragma("unroll") for (int _i = 0; _i < 2; ++_i) \
        __builtin_amdgcn_global_load_lds((const unsigned*)((const char*)(gbase) + (voff)[_i]), (PG8_LAS unsigned*)(lds + (bufoff) + ldsw + _i * 8192), 16, 0, 0); } while (0)
#define PG8_LDA(dst, b, h) do { _Pragma("unroll") for (int m = 0; m < 4; ++m) _Pragma("unroll") for (int k = 0; k < 2; ++k) dst[m][k] = *(const PG8_LAS bf16x8*)(lds + PG8_SA(b, h) + aoff + m * 2048 + k * 1024); } while (0)
#define PG8_LDB(dst, b, h) do { _Pragma("unroll") for (int n = 0; n < 2; ++n) _Pragma("unroll") for (int k = 0; k < 2; ++k) dst[n][k] = *(const PG8_LAS bf16x8*)(lds + PG8_SB(b, h) + boff + n * 2048 + k * 1024); } while (0)
#define PG8_MMA(ai, bj, At, Bt) do { __builtin_amdgcn_s_setprio(1); _Pragma("unroll") for (int m = 0; m < 4; ++m) _Pragma("unroll") for (int n = 0; n < 2; ++n) _Pragma("unroll") for (int k = 0; k < 2; ++k) \
        acc[ai][bj][m][n] = __builtin_amdgcn_mfma_f32_16x16x32_bf16(Bt[n][k], At[m][k], acc[ai][bj][m][n], 0, 0, 0); __builtin_amdgcn_s_setprio(0); } while (0)
#define PG8_WAIT_V(n) asm volatile("s_waitcnt vmcnt(" #n ")" ::: "memory")
#define PG8_WAIT_L(n) asm volatile("s_waitcnt lgkmcnt(" #n ")" ::: "memory")
#define PG8_BAR __builtin_amdgcn_s_barrier()
#define PG8_SCHED __builtin_amdgcn_sched_barrier(0)
    Unit cur, nxt; int ui = 0;
    if (!S.next(0, cur)) return;
    f32x4 acc[2][2][4][2];
#pragma unroll
    for (int a = 0; a < 2; ++a)
#pragma unroll
        for (int b = 0; b < 2; ++b)
#pragma unroll
            for (int m = 0; m < 4; ++m)
#pragma unroll
                for (int n = 0; n < 2; ++n) acc[a][b][m][n] = (f32x4){0.f, 0.f, 0.f, 0.f};
    bf16x8 At[4][2], B0[2][2], B1[2][2];
    const char* cA = (const char*)g.A + (size_t)cur.pm * tstep; const char* cB = (const char*)g.Bt + (size_t)cur.pn * tstep;
    S.a_ready(cur);
    if constexpr (SP2) {
        PG8_STAGE(PG8_SB(0, 0), cB, voffB); PG8_STAGE(PG8_SB(0, 1), cB + hstep, voffB); PG8_STAGE(PG8_SA(0, 0), cA, voffA); PG8_STAGE(PG8_SA(0, 1), cA + hstep, voffA);
        if (wr == 1) PG8_BAR;
        PG8_WAIT_V(2); PG8_BAR;
        PG8_STAGE(PG8_SB(1, 0), cB + kstep, voffB); PG8_STAGE(PG8_SA(1, 0), cA + kstep, voffA); PG8_STAGE(PG8_SB(1, 1), cB + hstep + kstep, voffB);
        PG8_WAIT_V(6); PG8_BAR;
    } else {
        PG8_STAGE(PG8_SB(0, 0), cB, voffB); PG8_STAGE(PG8_SA(0, 0), cA, voffA); PG8_STAGE(PG8_SB(0, 1), cB + hstep, voffB); PG8_STAGE(PG8_SA(0, 1), cA + hstep, voffA);
        if (wr == 1) PG8_BAR;
        PG8_WAIT_V(4); PG8_BAR;
        PG8_STAGE(PG8_SB(1, 0), cB + kstep, voffB); PG8_STAGE(PG8_SA(1, 0), cA + kstep, voffA); PG8_STAGE(PG8_SB(1, 1), cB + hstep + kstep, voffB);
        PG8_WAIT_V(6); PG8_BAR;
    }
    for (;;) {
        const bool has_next = S.next(ui + 1, nxt);
        const char* nA = has_next ? (const char*)g.A + (size_t)nxt.pm * tstep : cA; const char* nB = has_next ? (const char*)g.Bt + (size_t)nxt.pn * tstep : cB;
        for (int t = 0; t < nt; t += 2) {
            const bool last = (t == nt - 2);
            const char* a1 = cA + (size_t)(t + 1) * kstep;
            const char* a2 = last ? nA : cA + (size_t)(t + 2) * kstep; const char* b2 = last ? nB : cB + (size_t)(t + 2) * kstep;
            const char* a3 = a2 + kstep; const char* b3 = b2 + kstep;
            if (last && has_next) S.a_ready(nxt);
            if constexpr (SP2) {
            PG8_LDB(B0, 0, 0); PG8_LDB(B1, 0, 1); PG8_SCHED; PG8_LDA(At, 0, 0); PG8_STAGE(PG8_SA(1, 1), a1 + hstep, voffA);
            PG8_WAIT_V(8); PG8_WAIT_L(0); PG8_BAR; PG8_MMA(0, 0, At, B0); PG8_MMA(0, 1, At, B1); PG8_BAR; PG8_SCHED;
            PG8_LDA(At, 0, 1); PG8_STAGE(PG8_SB(0, 0), b2, voffB); PG8_STAGE(PG8_SB(0, 1), b2 + hstep, voffB); PG8_STAGE(PG8_SA(0, 0), a2, voffA);
            PG8_WAIT_V(8); PG8_WAIT_L(0); PG8_BAR; PG8_MMA(1, 0, At, B0); PG8_MMA(1, 1, At, B1); PG8_BAR; PG8_SCHED;
            PG8_LDB(B0, 1, 0); PG8_LDB(B1, 1, 1); PG8_SCHED; PG8_LDA(At, 1, 0); PG8_STAGE(PG8_SA(0, 1), a2 + hstep, voffA);
            PG8_WAIT_V(8); PG8_WAIT_L(0); PG8_BAR; PG8_MMA(0, 0, At, B0); PG8_MMA(0, 1, At, B1); PG8_BAR; PG8_SCHED;
            PG8_LDA(At, 1, 1); PG8_STAGE(PG8_SB(1, 0), b3, voffB); PG8_STAGE(PG8_SB(1, 1), b3 + hstep, voffB); PG8_STAGE(PG8_SA(1, 0), a3, voffA);
            PG8_WAIT_V(8); PG8_WAIT_L(0); PG8_BAR; PG8_MMA(1, 0, At, B0); PG8_MMA(1, 1, At, B1); PG8_BAR; PG8_SCHED;
            } else {
            PG8_LDB(B0, 0, 0); PG8_SCHED; PG8_LDA(At, 0, 0); PG8_STAGE(PG8_SA(1, 1), a1 + hstep, voffA);
            PG8_WAIT_L(8); PG8_BAR; PG8_WAIT_L(0); PG8_MMA(0, 0, At, B0); PG8_BAR; PG8_SCHED;
            PG8_LDB(B1, 0, 1); PG8_STAGE(PG8_SB(0, 0), b2, voffB);
            PG8_BAR; PG8_WAIT_L(0); PG8_MMA(0, 1, At, B1); PG8_BAR;
            PG8_LDA(At, 0, 1); PG8_STAGE(PG8_SA(0, 0), a2, voffA);
            PG8_BAR; PG8_WAIT_L(0); PG8_MMA(1, 0, At, B0); PG8_BAR; PG8_SCHED;
            PG8_STAGE(PG8_SB(0, 1), b2 + hstep, voffB);
            PG8_WAIT_V(6); PG8_BAR; PG8_MMA(1, 1, At, B1); PG8_BAR;
            PG8_LDB(B0, 1, 0); PG8_SCHED; PG8_LDA(At, 1, 0); PG8_STAGE(PG8_SA(0, 1), a2 + hstep, voffA);
            PG8_WAIT_L(8); PG8_BAR; PG8_WAIT_L(0); PG8_MMA(0, 0, At, B0); PG8_BAR; PG8_SCHED;
            PG8_LDB(B1, 1, 1); PG8_STAGE(PG8_SB(1, 0), b3, voffB);
            PG8_BAR; PG8_WAIT_L(0); PG8_MMA(0, 1, At, B1); PG8_BAR;
            PG8_LDA(At, 1, 1); PG8_STAGE(PG8_SA(1, 0), a3, voffA);
            PG8_BAR; PG8_WAIT_L(0); PG8_MMA(1, 0, At, B0); PG8_BAR; PG8_SCHED;
            PG8_STAGE(PG8_SB(1, 1), b3 + hstep, voffB);
            PG8_WAIT_V(6); PG8_BAR; PG8_MMA(1, 1, At, B1); PG8_BAR;
            }
        }
        if constexpr (ALIGN_EPI) { if (wr == 0) PG8_BAR; }
        if constexpr (!Epi::AFTER_DRAIN) { E(acc, cur, wr, wc, fr, fq); S.done(cur); }
        if (!has_next) break;
#pragma unroll
        for (int a = 0; a < 2; ++a)
#pragma unroll
            for (int b = 0; b < 2; ++b)
#pragma unroll
                for (int m = 0; m < 4; ++m)
#pragma unroll
                    for (int n = 0; n < 2; ++n) acc[a][b][m][n] = (f32x4){0.f, 0.f, 0.f, 0.f};
        cur = nxt; cA = nA; cB = nB; ++ui;
        if constexpr (ALIGN_EPI) { if (wr == 1) PG8_BAR; }
    }
    PG8_WAIT_V(0);
    if constexpr (!ALIGN_EPI) { if (wr == 0) PG8_BAR; }
    PG8_BAR;
    if constexpr (Epi::AFTER_DRAIN) { E.fused(acc, cur, wr, wc, fr, fq, lds, wid, lane); S.done(cur); }
#undef PG8_SA
#undef PG8_SB
#undef PG8_STAGE
#undef PG8_LDA
#undef PG8_LDB
#undef PG8_MMA
#undef PG8_WAIT_V
#undef PG8_WAIT_L
#undef PG8_BAR
#undef PG8_SCHED
}
}

typedef unsigned short bf16_t;
typedef short bf16x8 __attribute__((ext_vector_type(8)));
typedef float f32x4 __attribute__((ext_vector_type(4)));
typedef unsigned u32x4 __attribute__((ext_vector_type(4)));
typedef unsigned u32x2 __attribute__((ext_vector_type(2)));
using pg8::cvt_pk_bf16; using pg8::bf_lo; using pg8::bf_hi; using pg8::sigm;

constexpr int NB_ = 4, SEQ_ = 8192, T_ = NB_ * SEQ_, DM = 2048, DFF = 8192, INW = 10248, NZ = 10240;
constexpr float EPS_ = 1e-6f;
constexpr size_t MiB = 1u << 20;
constexpr size_t WS_RSQ1 = 0, WS_RSQ2 = (size_t)T_ * 4, WS_XBAR = 512 * 1024;
constexpr size_t WS_IF = 1 * MiB, WS_CS = 2 * MiB, WS_KM = 6 * MiB, WS_SEL = 7 * MiB, WS_LSE = 8 * MiB, WS_PB = 12 * MiB;
constexpr size_t WS_WIN = 28 * MiB, WS_WM = 68 * MiB, WS_WA = 72 * MiB, WS_WOUT = 76 * MiB, WS_W1 = 84 * MiB, WS_W2 = 116 * MiB, WS_WG = 148 * MiB, WS_WP = 156 * MiB;
constexpr size_t WS_XN = 160 * MiB, WS_HM = 160 * MiB, WS_HU = 224 * MiB, WS_QKC = 160 * MiB;
constexpr size_t WS_Z = 288 * MiB, PLANE = (size_t)T_ * 1024;
constexpr size_t WS_X1B = WS_Z + 512 * MiB;
constexpr size_t WS_HA = WS_Z, WS_TMP = WS_Z + 64 * MiB, WS_MG = WS_Z + 192 * MiB, WS_U = WS_Z, WS_PP = WS_Z + 512 * MiB;
constexpr size_t WS_GB = 928 * MiB, WS_GU = WS_GB + 512 * 1024, WS_GCM = WS_GU + 512 * 1024;
constexpr size_t WS_DUMP = 930 * MiB;
constexpr size_t WS_LG = 931 * MiB, WS_CI = 965 * MiB, WS_LD = 999 * MiB;
constexpr size_t WS_END = 1000 * MiB;
constexpr int LDS_BYTES = 163840;
enum { PL_QK = 0, PL_MV = 1, PL_MO = 2, PL_AQ = 3, PL_AK = 4, PL_AV = 5, PL_GM = 6, PL_GA = 8 };

struct Params {
    const float* x; const float* p; const int* positions; const float* attn_norm; const float* w_in; const float* b_if; const float* conv_w; const float* conv_b;
    const float* m_out_norm; const float* w_up_m; const float* w_up_a; const float* w_out; const float* mlp_norm; const float* w_ff1; const float* w_ff2;
    const float* ple_norm; const float* w_ple_gate; const float* w_ple_proj; const float* final_norm;
    float* out; unsigned char* ws;
};

__device__ __forceinline__ int opaque_tid() { int t_ = threadIdx.x; asm volatile("" : "+v"(t_)); return t_; }
__device__ __forceinline__ float wave_sum(float v) {
#pragma unroll
    for (int o = 32; o > 0; o >>= 1) v += __shfl_xor(v, o);
    return v;
}

#define LBAR() do { asm volatile("s_waitcnt lgkmcnt(0)" ::: "memory"); __builtin_amdgcn_s_barrier(); asm volatile("" ::: "memory"); } while (0)
template <int K, int N, int LDS_, bool WIN> __device__ __forceinline__ void wmat(const float* src, bf16_t* dst, int base, unsigned char* lds) {
    const int tid = threadIdx.x; constexpr int LD = 260, nN = N / 256, NT = nN * (K / 64);
    float* tl0 = (float*)lds; float* tl1 = tl0 + 64 * LD;
    const int G = gridDim.x; int t = ((int)blockIdx.x - base % G + G) % G;
    float4 r0, r1, r2, r3, r4, r5, r6, r7;
#define WLOAD(tt_) do { const int k0_ = ((tt_) / nN) * 64, n0_ = ((tt_) % nN) * 256; const float* b_ = src + (size_t)(k0_ + (tid >> 6)) * LDS_ + ((WIN && n0_ >= 3072) ? 8 : 0) + n0_ + (tid & 63) * 4; constexpr size_t st_ = (size_t)8 * LDS_; \
        r0 = *(const float4*)b_; r1 = *(const float4*)(b_ + st_); r2 = *(const float4*)(b_ + 2 * st_); r3 = *(const float4*)(b_ + 3 * st_); \
        r4 = *(const float4*)(b_ + 4 * st_); r5 = *(const float4*)(b_ + 5 * st_); r6 = *(const float4*)(b_ + 6 * st_); r7 = *(const float4*)(b_ + 7 * st_); } while (0)
    if (t < NT) WLOAD(t);
    int par = 0;
    for (; t < NT; t += G) {
        float* tl = par ? tl1 : tl0;
        { float* wp = tl + (tid >> 6) * LD + (tid & 63) * 4;
          *(float4*)wp = r0; *(float4*)(wp + 8 * LD) = r1; *(float4*)(wp + 16 * LD) = r2; *(float4*)(wp + 24 * LD) = r3;
          *(float4*)(wp + 32 * LD) = r4; *(float4*)(wp + 40 * LD) = r5; *(float4*)(wp + 48 * LD) = r6; *(float4*)(wp + 56 * LD) = r7; }
        if (t + G < NT) WLOAD(t + G);
        LBAR();
        { const int nn = tid & 255, k0 = (t / nN) * 64, n0 = (t % nN) * 256;
#pragma unroll
          for (int i = 0; i < 4; ++i) { const int k8 = ((tid >> 8) + 2 * i) * 8; const float* rp = tl + k8 * LD + nn;
              u32x4 w; w.x = cvt_pk_bf16(rp[0], rp[LD]); w.y = cvt_pk_bf16(rp[2 * LD], rp[3 * LD]); w.z = cvt_pk_bf16(rp[4 * LD], rp[5 * LD]); w.w = cvt_pk_bf16(rp[6 * LD], rp[7 * LD]);
              *(u32x4*)(dst + (size_t)(n0 + nn) * K + k0 + k8) = w; } }
        par ^= 1;
    }
#undef WLOAD
    __syncthreads();
}
__device__ void weights_phase(const Params& P, unsigned char* lds) {
    unsigned char* ws = P.ws;
    wmat<2048, NZ, INW, true>(P.w_in, (bf16_t*)(ws + WS_WIN), 0, lds);
    wmat<2048, 8192, 8192, false>(P.w_ff1, (bf16_t*)(ws + WS_W1), 1280, lds);
    wmat<8192, 2048, 2048, false>(P.w_ff2, (bf16_t*)(ws + WS_W2), 2304, lds);
    wmat<2048, 2048, 2048, false>(P.w_out, (bf16_t*)(ws + WS_WOUT), 3328, lds);
    wmat<2048, 2048, 2048, false>(P.w_ple_gate, (bf16_t*)(ws + WS_WG), 3584, lds);
    wmat<1024, 2048, 2048, false>(P.w_up_m, (bf16_t*)(ws + WS_WM), 3840, lds);
    wmat<1024, 2048, 2048, false>(P.w_up_a, (bf16_t*)(ws + WS_WA), 3968, lds);
    wmat<256, 2048, 2048, false>(P.w_ple_proj, (bf16_t*)(ws + WS_WP), 4096, lds);
}
template <int MODE> __device__ void rms_phase(const float* X, const float* g, bf16_t* ob, float* of, const Params& P, unsigned char* lds) {
    const int tid = threadIdx.x, lane = tid & 63, wid = tid >> 6;
    float* wg = (float*)lds;
    if (MODE == 0) {
        for (int i = tid; i < 8 * 2048; i += 512) { const int c = i & 7, k = i >> 3; wg[c * 2048 + k] = P.w_in[(size_t)k * INW + 3072 + c]; }
        __syncthreads();
    }
    float4 gv[8];
#pragma unroll
    for (int j = 0; j < 8; ++j) gv[j] = *(const float4*)(g + j * 256 + lane * 4);
    for (int row = blockIdx.x * 8 + wid; row < T_; row += gridDim.x * 8) {
        const float* xr = X + (size_t)row * DM;
        float4 v[8]; float ss = 0.f;
#pragma unroll
        for (int j = 0; j < 8; ++j) { v[j] = *(const float4*)(xr + j * 256 + lane * 4); ss += v[j].x * v[j].x + v[j].y * v[j].y + v[j].z * v[j].z + v[j].w * v[j].w; }
        ss = wave_sum(ss);
        const float rinv = rsqrtf(ss * (1.0f / DM) + EPS_);
#pragma unroll
        for (int j = 0; j < 8; ++j) { v[j].x = v[j].x * rinv * gv[j].x; v[j].y = v[j].y * rinv * gv[j].y; v[j].z = v[j].z * rinv * gv[j].z; v[j].w = v[j].w * rinv * gv[j].w; }
        if (MODE == 2) {
#pragma unroll
            for (int j = 0; j < 8; ++j) *(float4*)(of + (size_t)row * DM + j * 256 + lane * 4) = v[j];
        } else {
#pragma unroll
            for (int j = 0; j < 8; ++j) { u32x2 w; w.x = cvt_pk_bf16(v[j].x, v[j].y); w.y = cvt_pk_bf16(v[j].z, v[j].w); *(u32x2*)(ob + (size_t)row * DM + j * 256 + lane * 4) = w; }
        }
        if (MODE == 0) {
            float a[8];
#pragma unroll
            for (int c = 0; c < 8; ++c) { float s = 0.f;
#pragma unroll
                for (int j = 0; j < 8; ++j) { const float4 w = *(const float4*)(wg + c * 2048 + j * 256 + lane * 4); s += v[j].x * w.x + v[j].y * w.y + v[j].z * w.z + v[j].w * w.w; }
                a[c] = wave_sum(s); }
            if (lane < 8) { float s = a[0];
#pragma unroll
                for (int c = 1; c < 8; ++c) s = (lane == c) ? a[c] : s;
                ((float*)(P.ws + WS_IF))[(size_t)row * 8 + lane] = s + P.b_if[lane]; }
        }
    }
}
__device__ void misc_prologue(const Params& P) {
    const size_t gt = (size_t)blockIdx.x * 512 + threadIdx.x, gs = (size_t)gridDim.x * 512;
    { float* z = (float*)(P.ws + WS_RSQ1); for (size_t i = gt; i < (size_t)2 * T_; i += gs) z[i] = 0.f; }
    bf16_t* pb = (bf16_t*)(P.ws + WS_PB);
    for (size_t i = gt; i < (size_t)T_ * 256 / 4; i += gs) { const float4 v = *(const float4*)(P.p + i * 4); u32x2 w; w.x = cvt_pk_bf16(v.x, v.y); w.y = cvt_pk_bf16(v.z, v.w); *(u32x2*)(pb + i * 4) = w; }
    float2* cs = (float2*)(P.ws + WS_CS);
    for (size_t i = gt; i < (size_t)T_ * 16; i += gs) { const int t = (int)(i >> 4), f = (int)(i & 15);
        const float invf = (float)pow(500000.0, -(double)f / 16.0); const float ang = (float)P.positions[t] * invf;
        float s, c; sincosf(ang, &s, &c); cs[i] = make_float2(c, s); }
}

__device__ void moba_prep_phase(const Params& P, unsigned char* lds) {
    const int tid = threadIdx.x, rr = tid >> 4, ch = tid & 15;
    float* red = (float*)lds;
    bf16_t* AQ = (bf16_t*)(P.ws + WS_Z) + PL_AQ * PLANE; bf16_t* AK = (bf16_t*)(P.ws + WS_Z) + PL_AK * PLANE;
    const float2* cs = (const float2*)(P.ws + WS_CS); float* KM = (float*)(P.ws + WS_KM);
    for (int u = blockIdx.x; u < 1024; u += gridDim.x) {
        const int b = u >> 8, j = (u >> 3) & 31, h = u & 7; const int r0 = b * SEQ_ + j * 256;
        float ks[8];
#pragma unroll
        for (int e = 0; e < 8; ++e) ks[e] = 0.f;
        for (int pb = 0; pb < 4; ++pb) {
            u32x4 wq[2], wk[2]; float4 cv[2][4]; size_t offs[2];
#pragma unroll
            for (int i = 0; i < 2; ++i) { const int row = r0 + (pb * 2 + i) * 32 + rr; offs[i] = (size_t)row * 1024 + h * 128 + ch * 8;
                wq[i] = *(const u32x4*)(AQ + offs[i]); wk[i] = *(const u32x4*)(AK + offs[i]);
                if (ch < 4) { const float4* cp = (const float4*)(cs + (size_t)row * 16 + (ch & 1) * 8);
#pragma unroll
                    for (int q4 = 0; q4 < 4; ++q4) cv[i][q4] = cp[q4]; }
                else {
#pragma unroll
                    for (int q4 = 0; q4 < 4; ++q4) cv[i][q4] = make_float4(1.f, 0.f, 1.f, 0.f); } }
#pragma unroll
            for (int i = 0; i < 2; ++i) {
#pragma unroll
                for (int which = 0; which < 2; ++which) { bf16_t* pl = which ? AK : AQ; const u32x4 w = which ? wk[i] : wq[i];
                    float x[8] = {bf_lo(w.x), bf_hi(w.x), bf_lo(w.y), bf_hi(w.y), bf_lo(w.z), bf_hi(w.z), bf_lo(w.w), bf_hi(w.w)};
                    float y[8];
#pragma unroll
                    for (int e = 0; e < 8; ++e) { const float o = __shfl_xor(x[e], 2);
                        const float4 c4 = cv[i][e >> 1]; const float cc = (e & 1) ? c4.z : c4.x, sn = (e & 1) ? c4.w : c4.y;
                        y[e] = (ch < 2) ? (x[e] * cc - o * sn) : (x[e] * cc + o * sn); }
                    if (which == 0) {
#pragma unroll
                        for (int e = 0; e < 8; ++e) y[e] *= 0.12751743074602468f;
                    } else {
#pragma unroll
                        for (int e = 0; e < 8; ++e) ks[e] += y[e];
                    }
                    u32x4 o; o.x = cvt_pk_bf16(y[0], y[1]); o.y = cvt_pk_bf16(y[2], y[3]); o.z = cvt_pk_bf16(y[4], y[5]); o.w = cvt_pk_bf16(y[6], y[7]);
                    *(u32x4*)(pl + offs[i]) = o; } } }
#pragma unroll
        for (int e = 0; e < 8; ++e) red[rr * 128 + ch * 8 + e] = ks[e];
        __syncthreads();
        if (tid < 128) { float s = 0.f;
            for (int r = 0; r < 32; ++r) s += red[r * 128 + tid];
            KM[((size_t)((b * 8 + h) * 32 + j)) * 128 + tid] = s * (1.0f / 256.0f); }
        __syncthreads();
    }
}
__device__ void moba_route_phase(const Params& P, unsigned char* lds) {
    const int tid = threadIdx.x, lane = tid & 63, wid = tid >> 6, fr = lane & 15, fq = lane >> 4;
    bf16_t* kmh = (bf16_t*)lds;
    bf16_t* kml = kmh + 32 * 136;
    float* sc = (float*)(lds + 32768);
    const bf16_t* AQ = (const bf16_t*)(P.ws + WS_Z) + PL_AQ * PLANE; const float* KM = (const float*)(P.ws + WS_KM); unsigned* SEL = (unsigned*)(P.ws + WS_SEL);
    for (int u = blockIdx.x; u < 1024; u += gridDim.x) {
        const int bh = u & 31, c = u >> 5, b = bh >> 3, h = bh & 7;
        if (c == 0) { if (tid < 256) SEL[(size_t)bh * SEQ_ + tid] = 0xFFFFFFu; continue; }
        bf16x8 qa[2][4];
#pragma unroll
        for (int mt = 0; mt < 2; ++mt) { const bf16_t* q = AQ + (size_t)(b * SEQ_ + c * 256 + wid * 32 + mt * 16 + fr) * 1024 + h * 128 + fq * 8;
#pragma unroll
            for (int ks = 0; ks < 4; ++ks) qa[mt][ks] = *(const bf16x8*)(q + ks * 32); }
        for (int i = tid; i < 32 * 128; i += 512) { const int n = i >> 7, d = i & 127; const float v = (n < c) ? KM[(size_t)bh * 32 * 128 + i] : 0.f;
            const unsigned hi = cvt_pk_bf16(v, 0.f) & 0xffffu; const float r = v - __builtin_bit_cast(float, hi << 16);
            kmh[n * 136 + d] = (bf16_t)hi; kml[n * 136 + d] = (bf16_t)(cvt_pk_bf16(r, 0.f) & 0xffffu); }
        __syncthreads();
#pragma unroll
        for (int nt = 0; nt < 2; ++nt) { bf16x8 bh_[4], bl_[4];
#pragma unroll
            for (int ks = 0; ks < 4; ++ks) { bh_[ks] = *(const bf16x8*)(kmh + (nt * 16 + fr) * 136 + ks * 32 + fq * 8); bl_[ks] = *(const bf16x8*)(kml + (nt * 16 + fr) * 136 + ks * 32 + fq * 8); }
#pragma unroll
            for (int mt = 0; mt < 2; ++mt) { f32x4 a4 = (f32x4){0.f, 0.f, 0.f, 0.f};
#pragma unroll
                for (int ks = 0; ks < 4; ++ks) { a4 = __builtin_amdgcn_mfma_f32_16x16x32_bf16(qa[mt][ks], bl_[ks], a4, 0, 0, 0); a4 = __builtin_amdgcn_mfma_f32_16x16x32_bf16(qa[mt][ks], bh_[ks], a4, 0, 0, 0); }
#pragma unroll
                for (int jj = 0; jj < 4; ++jj) sc[(wid * 32 + mt * 16 + fq * 4 + jj) * 33 + nt * 16 + fr] = a4[jj]; } }
        __syncthreads();
        if (tid < 256) { float b0 = -INFINITY, b1 = -INFINITY, b2 = -INFINITY; unsigned i0 = 0xFF, i1 = 0xFF, i2 = 0xFF;
            for (int n = 0; n < c; ++n) { const float s = sc[tid * 33 + n];
                if (s > b0) { b2 = b1; i2 = i1; b1 = b0; i1 = i0; b0 = s; i0 = n; }
                else if (s > b1) { b2 = b1; i2 = i1; b1 = s; i1 = n; }
                else if (s > b2) { b2 = s; i2 = n; } }
            SEL[(size_t)bh * SEQ_ + c * 256 + tid] = i0 | (i1 << 8) | (i2 << 16); }
        __syncthreads();
    }
}
struct MobaDef { u32x4 v[4]; float lse; bf16_t* op; float* lp; bool val; };
template <bool OWN, bool DEFER = false> __device__ __forceinline__ void moba_group(const bf16_t* Kl, const bf16_t* VTl, bf16x8 (&bq)[4], int g, int rcaus, bool valid, size_t ro, bf16_t* OP, float* LSE, int fr, int fq,
                                                                             MobaDef& D, const bf16_t* nq, bool has_next) {
#define MG_SCHED __builtin_amdgcn_sched_barrier(0)
    f32x4 acc[16];
    const bf16_t* kp = Kl + fr * 136 + fq * 8;
    bf16x8 ka[4][4];
#pragma unroll
    for (int pm = 0; pm < 3; ++pm)
#pragma unroll
        for (int ks = 0; ks < 4; ++ks) ka[pm][ks] = *(const bf16x8*)(kp + pm * 16 * 136 + ks * 32);
#pragma unroll
    for (int mt = 0; mt < 16; ++mt) {
        if (mt < 13) {
#pragma unroll
            for (int ks = 0; ks < 4; ++ks) ka[(mt + 3) & 3][ks] = *(const bf16x8*)(kp + (mt + 3) * 16 * 136 + ks * 32); }
        MG_SCHED;
        if (!OWN || mt <= g) { acc[mt] = (f32x4){0.f, 0.f, 0.f, 0.f};
#pragma unroll
            for (int ks = 0; ks < 4; ++ks) acc[mt] = __builtin_amdgcn_mfma_f32_16x16x32_bf16(ka[mt & 3][ks], bq[ks], acc[mt], 0, 0, 0); }
        else acc[mt] = (f32x4){-INFINITY, -INFINITY, -INFINITY, -INFINITY};
        MG_SCHED; }
    if (DEFER) {
        if (D.val) {
#pragma unroll
            for (int p = 0; p < 4; ++p) *(u32x4*)(D.op + p * 32) = D.v[p];
            if (fq == 0) *D.lp = D.lse; }
        if (has_next) {
#pragma unroll
            for (int ks = 0; ks < 4; ++ks) bq[ks] = *(const bf16x8*)(nq + ks * 32); } }
    const bf16_t* vp0 = VTl + fr * 264 + fq * 8;
    u32x4 va[4][4];
#pragma unroll
    for (int s = 0; s < 3; ++s)
#pragma unroll
        for (int d = 0; d < 4; ++d) va[s][d] = *(const u32x4*)(vp0 + ((s & 1) * 4 + d) * 16 * 264 + (s >> 1) * 32);
    float mx = -INFINITY;
#pragma unroll
    for (int mt = 0; mt < 16; ++mt)
#pragma unroll
        for (int jj = 0; jj < 4; ++jj) { float s = acc[mt][jj]; if (OWN) { const int key = mt * 16 + fq * 4 + jj; s = (key > rcaus) ? -INFINITY : s; acc[mt][jj] = s; } mx = fmaxf(mx, s); }
    mx = fmaxf(mx, __shfl_xor(mx, 16)); mx = fmaxf(mx, __shfl_xor(mx, 32));
    float l = 0.f;
#pragma unroll
    for (int mt = 0; mt < 16; ++mt)
#pragma unroll
        for (int jj = 0; jj < 4; ++jj) { const float pv = __builtin_amdgcn_exp2f(acc[mt][jj] - mx); acc[mt][jj] = pv; l += pv; }
    l += __shfl_xor(l, 16); l += __shfl_xor(l, 32);
    f32x4 o[8];
#pragma unroll
    for (int dt = 0; dt < 8; ++dt) o[dt] = (f32x4){0.f, 0.f, 0.f, 0.f};
    bf16x8 pb;
#pragma unroll
    for (int s = 0; s < 16; ++s) { const int k2 = s >> 1;
        if (s < 13) {
#pragma unroll
            for (int d = 0; d < 4; ++d) va[(s + 3) & 3][d] = *(const u32x4*)(vp0 + (((s + 3) & 1) * 4 + d) * 16 * 264 + ((s + 3) >> 1) * 32); }
        MG_SCHED;
        if (!OWN || 2 * k2 <= g) {
            if ((s & 1) == 0) { u32x4 pw; pw.x = cvt_pk_bf16(acc[2 * k2][0], acc[2 * k2][1]); pw.y = cvt_pk_bf16(acc[2 * k2][2], acc[2 * k2][3]);
                pw.z = cvt_pk_bf16(acc[2 * k2 + 1][0], acc[2 * k2 + 1][1]); pw.w = cvt_pk_bf16(acc[2 * k2 + 1][2], acc[2 * k2 + 1][3]);
                pb = __builtin_bit_cast(bf16x8, pw); }
#pragma unroll
            for (int d = 0; d < 4; ++d) o[(s & 1) * 4 + d] = __builtin_amdgcn_mfma_f32_16x16x32_bf16(__builtin_bit_cast(bf16x8, va[s & 3][d]), pb, o[(s & 1) * 4 + d], 0, 0, 0); }
        MG_SCHED; }
    {
      const float inv = __builtin_amdgcn_rcpf(l);
      u32x2 w[8];
#pragma unroll
      for (int dt = 0; dt < 8; ++dt) { w[dt].x = cvt_pk_bf16(o[dt][0] * inv, o[dt][1] * inv); w[dt].y = cvt_pk_bf16(o[dt][2] * inv, o[dt][3] * inv); }
      bf16_t* op = OP + ro * 128 + ((fq & 1) ? 16 + (fq - 1) * 4 : fq * 4);
#pragma unroll
      for (int p = 0; p < 4; ++p) { const u32x2 rx = __builtin_amdgcn_permlane16_swap(w[2 * p].x, w[2 * p + 1].x, false, false), ry = __builtin_amdgcn_permlane16_swap(w[2 * p].y, w[2 * p + 1].y, false, false);
          u32x4 v; v.x = rx[0]; v.y = ry[0]; v.z = rx[1]; v.w = ry[1];
          if (DEFER) D.v[p] = v; else if (valid) *(u32x4*)(op + p * 32) = v; }
      const float lse2 = mx + __builtin_amdgcn_logf(l);
      if (DEFER) { D.op = op; D.lp = LSE + ro; D.lse = lse2; D.val = valid; } else if (valid && fq == 0) LSE[ro] = lse2; }
#undef MG_SCHED
}
__device__ void moba_unit(const Params& P, int b, int h, int j, unsigned char* lds) {
    const int tid = threadIdx.x, lane = tid & 63, wid = tid >> 6, fr = lane & 15, fq = lane >> 4;
    bf16_t* Kl = (bf16_t*)lds;
    bf16_t* VTl = (bf16_t*)(lds + 69632);
    unsigned short* list = (unsigned short*)(lds + 139264);
    int* cnt = (int*)(lds + 139264 + 15872);
    const bf16_t* AQ = (const bf16_t*)(P.ws + WS_Z) + PL_AQ * PLANE; const bf16_t* AK = (const bf16_t*)(P.ws + WS_Z) + PL_AK * PLANE; const bf16_t* AV = (const bf16_t*)(P.ws + WS_Z) + PL_AV * PLANE;
    const unsigned* SEL = (const unsigned*)(P.ws + WS_SEL); float* LSE = (float*)(P.ws + WS_LSE); bf16_t* OP = (bf16_t*)P.out;
    const int bh = b * 8 + h; const size_t base = (size_t)b * SEQ_ + (size_t)j * 256;
    __syncthreads();
    if (tid == 0) *cnt = 0;
    { const int r = tid >> 1, hf = tid & 1; const size_t go = (base + r) * 1024 + h * 128 + hf * 64;
      const int cr = (r & ~31) | (((r >> 2) & 3) << 3) | (((r >> 4) & 1) << 2) | (r & 3);
      u32x4 kv[8], vv[8];
#pragma unroll
      for (int i = 0; i < 8; ++i) { kv[i] = *(const u32x4*)(AK + go + i * 8); vv[i] = *(const u32x4*)(AV + go + i * 8); }
#pragma unroll
      for (int i = 0; i < 8; ++i) *(u32x4*)(Kl + r * 136 + hf * 64 + i * 8) = kv[i];
#pragma unroll
      for (int i = 0; i < 8; ++i) { const int d0 = hf * 64 + i * 8;
          VTl[(d0 + 0) * 264 + cr] = (bf16_t)(vv[i].x & 0xffff); VTl[(d0 + 1) * 264 + cr] = (bf16_t)(vv[i].x >> 16);
          VTl[(d0 + 2) * 264 + cr] = (bf16_t)(vv[i].y & 0xffff); VTl[(d0 + 3) * 264 + cr] = (bf16_t)(vv[i].y >> 16);
          VTl[(d0 + 4) * 264 + cr] = (bf16_t)(vv[i].z & 0xffff); VTl[(d0 + 5) * 264 + cr] = (bf16_t)(vv[i].z >> 16);
          VTl[(d0 + 6) * 264 + cr] = (bf16_t)(vv[i].w & 0xffff); VTl[(d0 + 7) * 264 + cr] = (bf16_t)(vv[i].w >> 16); } }
    __syncthreads();
    for (int t0 = (j + 1) * 256 + tid; t0 < SEQ_; t0 += 2048) {
        unsigned sv[4];
#pragma unroll
        for (int q = 0; q < 4; ++q) { const int t = t0 + q * 512; sv[q] = (t < SEQ_) ? SEL[(size_t)bh * SEQ_ + t] : 0xFFFFFFFFu; }
#pragma unroll
        for (int q = 0; q < 4; ++q) { const unsigned s = sv[q]; const int t = t0 + q * 512;
            const int sl = ((s & 0xFF) == (unsigned)j) ? 0 : (((s >> 8) & 0xFF) == (unsigned)j) ? 1 : (((s >> 16) & 0xFF) == (unsigned)j) ? 2 : -1;
            if (sl >= 0 && t < SEQ_) { const int pos = atomicAdd(cnt, 1); list[pos] = (unsigned short)(t | (sl << 13)); } } }
    __syncthreads();
    const int nl = *cnt, NGg = (nl + 15) / 16;
    const size_t qb = (size_t)b * SEQ_;
    { bf16x8 bq[4], bn[4]; MobaDef D0; D0.val = false;
      { const bf16_t* qrow = AQ + (qb + j * 256 + wid * 16 + fr) * 1024 + h * 128;
#pragma unroll
        for (int ks = 0; ks < 4; ++ks) bq[ks] = *(const bf16x8*)(qrow + ks * 32 + fq * 8); }
      { const bf16_t* qrow = AQ + (qb + j * 256 + (wid + 8) * 16 + fr) * 1024 + h * 128;
#pragma unroll
        for (int ks = 0; ks < 4; ++ks) bn[ks] = *(const bf16x8*)(qrow + ks * 32 + fq * 8); }
      { const int rc = wid * 16 + fr; moba_group<true>(Kl, VTl, bq, wid, rc, true, ((qb + j * 256 + rc) * 8 + h) * 4 + 3, OP, LSE, fr, fq, D0, AQ, false); }
      { const int rc = (wid + 8) * 16 + fr; moba_group<true>(Kl, VTl, bn, wid + 8, rc, true, ((qb + j * 256 + rc) * 8 + h) * 4 + 3, OP, LSE, fr, fq, D0, AQ, false); } }
    if (wid < NGg) {
        bf16x8 bq[4]; int gi = wid;
        int idx = gi * 16 + fr; bool valid = idx < nl; unsigned e = list[valid ? idx : 0];
        { const bf16_t* qrow = AQ + (qb + (e & 0x1FFF)) * 1024 + h * 128;
#pragma unroll
          for (int ks = 0; ks < 4; ++ks) bq[ks] = *(const bf16x8*)(qrow + ks * 32 + fq * 8); }
        MobaDef D; D.val = false; D.op = OP; D.lp = LSE; D.lse = 0.f;
#pragma unroll
        for (int p = 0; p < 4; ++p) D.v[p] = (u32x4){0u, 0u, 0u, 0u};
        for (;;) {
            const int gn = gi + 8; const bool hn = gn < NGg;
            unsigned en = 0; bool vn = false;
            if (hn) { const int idn = gn * 16 + fr; vn = idn < nl; en = list[vn ? idn : 0]; }
            const bf16_t* nq = AQ + (qb + (en & 0x1FFF)) * 1024 + h * 128 + fq * 8;
            moba_group<false, true>(Kl, VTl, bq, 0, 0, valid, ((qb + (e & 0x1FFF)) * 8 + h) * 4 + (e >> 13), OP, LSE, fr, fq, D, nq, hn);
            if (!hn) break;
            e = en; valid = vn; gi = gn;
        }
        if (D.val) {
#pragma unroll
            for (int p = 0; p < 4; ++p) *(u32x4*)(D.op + p * 32) = D.v[p];
            if (fq == 0) *D.lp = D.lse; }
    }
}
__device__ __forceinline__ float logsig(float x) { return fminf(x, 0.f) - log1pf(expf(-fabsf(x))); }
__device__ void mlstm_prep_phase(const Params& P) {
    const int tid = threadIdx.x, lane = tid & 63, wid = tid >> 6;
    const bf16_t* QK = (const bf16_t*)(P.ws + WS_Z) + PL_QK * PLANE; bf16_t* QKC = (bf16_t*)(P.ws + WS_QKC);
    const int gtid = blockIdx.x * 512 + tid, gs = gridDim.x * 512;
    if ((gs & 127) == 0) {
        const int col = (gtid & 127) * 8;
        float cw[4][8], cb[8];
#pragma unroll
        for (int jt = 0; jt < 4; ++jt)
#pragma unroll
            for (int c = 0; c < 8; ++c) cw[jt][c] = P.conv_w[jt * 1024 + col + c];
#pragma unroll
        for (int c = 0; c < 8; ++c) cb[c] = P.conv_b[col + c];
        const float oscale = (col >= 512) ? 0.08838834764831845f : 1.0f;
        for (int task = gtid; task < (T_ / 4) * 128; task += gs) {
            const int row0 = (task >> 7) * 4, tin = row0 & (SEQ_ - 1);
            float xr[7][8];
#pragma unroll
            for (int r = 0; r < 7; ++r) { u32x4 w = (u32x4){0u, 0u, 0u, 0u};
                if (tin - 3 + r >= 0) w = *(const u32x4*)(QK + (size_t)(row0 - 3 + r) * 1024 + col);
                xr[r][0] = bf_lo(w.x); xr[r][1] = bf_hi(w.x); xr[r][2] = bf_lo(w.y); xr[r][3] = bf_hi(w.y); xr[r][4] = bf_lo(w.z); xr[r][5] = bf_hi(w.z); xr[r][6] = bf_lo(w.w); xr[r][7] = bf_hi(w.w); }
#pragma unroll
            for (int i = 0; i < 4; ++i) { float y[8];
#pragma unroll
                for (int c = 0; c < 8; ++c) { const float s = cb[c] + cw[0][c] * xr[i][c] + cw[1][c] * xr[i + 1][c] + cw[2][c] * xr[i + 2][c] + cw[3][c] * xr[i + 3][c]; y[c] = s * sigm(s) * oscale; }
                u32x4 w; w.x = cvt_pk_bf16(y[0], y[1]); w.y = cvt_pk_bf16(y[2], y[3]); w.z = cvt_pk_bf16(y[4], y[5]); w.w = cvt_pk_bf16(y[6], y[7]);
                *(u32x4*)(QKC + (size_t)(row0 + i) * 1024 + col) = w; }
        }
    }
    const float* IF = (const float*)(P.ws + WS_IF); float* GB = (float*)(P.ws + WS_GB); float* GU = (float*)(P.ws + WS_GU); float* GCM = (float*)(P.ws + WS_GCM);
    for (int wt = blockIdx.x * 8 + wid; wt < 16 * 128; wt += gridDim.x * 8) { const int bh = wt >> 7, n = wt & 127, b = bh >> 2, h = bh & 3;
        const size_t row = (size_t)b * SEQ_ + n * 64 + lane;
        const float ig = IF[row * 8 + h], fp = IF[row * 8 + 4 + h];
        float bs = logsig(fp);
#pragma unroll
        for (int d = 1; d < 64; d <<= 1) { const float t = __shfl_up(bs, d); if (lane >= d) bs += t; }
        const float u = ig - bs; float cm = u;
#pragma unroll
        for (int d = 1; d < 64; d <<= 1) { const float t = __shfl_up(cm, d); if (lane >= d) cm = fmaxf(cm, t); }
        const size_t o = (size_t)bh * SEQ_ + n * 64 + lane; GB[o] = bs; GU[o] = u; GCM[o] = cm; }
}
template <bool FULL> __device__ void mlstm_seg(const Params& P, int unit, unsigned char* lds) {
    const int tid = opaque_tid(), lane = tid & 63, wid = tid >> 6, fr = lane & 15, fq = lane >> 4;
    const int bh = unit >> 4, seg = unit & 15, b = bh >> 2, h = bh & 3;
    bf16_t* Qs = (bf16_t*)lds;
    bf16_t* Ks = Qs + 64 * 136;
    bf16_t* KsT = Ks + 64 * 136;
    bf16_t* KWT = KsT + 128 * 72;
    bf16_t* VT = KWT + 128 * 72;
    bf16_t* Ps = VT + 256 * 72;
    float* FL = (float*)(Ps + 64 * 72);
    float* NV = FL + 512;
    const bf16_t* QKC = (const bf16_t*)(P.ws + WS_QKC); const bf16_t* MV = (const bf16_t*)(P.ws + WS_Z) + PL_MV * PLANE;
    const float* GB = (const float*)(P.ws + WS_GB) + (size_t)bh * SEQ_; const float* GU = (const float*)(P.ws + WS_GU) + (size_t)bh * SEQ_; const float* GCM = (const float*)(P.ws + WS_GCM) + (size_t)bh * SEQ_;
    bf16_t* HU = (bf16_t*)(P.ws + WS_HU); float* LG = (float*)(P.ws + WS_LG); const float* CI = (const float*)(P.ws + WS_CI); float* LDp = (float*)(P.ws + WS_LD);
    __syncthreads();
    const int n0 = seg * 8;
    float m_prev = 0.f, dprod = 1.f;
    if (wid == 0) {
#pragma unroll
        for (int rnd = 0; rnd < 2; ++rnd) { const int n = rnd * 64 + lane; float a = 0.f, bb = -INFINITY;
            if (n < n0) { const float g = GB[n * 64 + 63], c = GCM[n * 64 + 63]; a = g; bb = c + g; }
#pragma unroll
            for (int d = 1; d < 64; d <<= 1) { const float ta = __shfl_up(a, d), tb = __shfl_up(bb, d); if (lane >= d) { bb = fmaxf(tb + a, bb); a = ta + a; } }
            const float A = __shfl(a, 63), B = __shfl(bb, 63); m_prev = fmaxf(m_prev + A, B); }
    }
    const int cs0 = wid, cs1 = wid + 8;
    f32x4 Cacc[8][2];
#pragma unroll
    for (int dt = 0; dt < 8; ++dt)
#pragma unroll
        for (int s = 0; s < 2; ++s) { Cacc[dt][s] = (f32x4){0.f, 0.f, 0.f, 0.f};
            if (FULL) { const int c = (s == 0 ? cs0 : cs1) * 16 + fr;
                Cacc[dt][s] = *(const f32x4*)(CI + ((size_t)unit * 272 + c) * 128 + dt * 16 + fq * 4); } }
    float nreg = 0.f;
    if (tid < 128) { if (FULL) nreg = CI[((size_t)unit * 272 + 256) * 128 + tid]; NV[tid] = nreg; }
    const int cgI = tid & 31, rg = tid >> 5, isK = cgI >> 4, chl = (cgI & 15) * 8, col = isK * 512 + h * 128 + chl, l0 = rg * 4;
    const int vg = tid & 31, tg = tid >> 5;
    const size_t seqb = (size_t)b * SEQ_;
#pragma unroll 1
    for (int k = 0; k < 8; ++k) {
        const int n = n0 + k; const size_t rowb = seqb + (size_t)n * 64;
        if (FULL || isK) { u32x4 rq[4];
#pragma unroll
            for (int i = 0; i < 4; ++i) rq[i] = *(const u32x4*)(QKC + (rowb + l0 + i) * 1024 + col);
            bf16_t* dst = isK ? Ks : Qs;
#pragma unroll
            for (int i = 0; i < 4; ++i) *(u32x4*)(dst + (l0 + i) * 136 + chl) = rq[i];
            if (isK) { const unsigned q0[4] = {rq[0].x, rq[0].y, rq[0].z, rq[0].w}, q1[4] = {rq[1].x, rq[1].y, rq[1].z, rq[1].w}, q2[4] = {rq[2].x, rq[2].y, rq[2].z, rq[2].w}, q3[4] = {rq[3].x, rq[3].y, rq[3].z, rq[3].w};
#pragma unroll
                for (int c2 = 0; c2 < 4; ++c2) { u32x2 wl, wh;
                    wl.x = (q0[c2] & 0xffffu) | (q1[c2] << 16); wl.y = (q2[c2] & 0xffffu) | (q3[c2] << 16);
                    wh.x = (q0[c2] >> 16) | (q1[c2] & 0xffff0000u); wh.y = (q2[c2] >> 16) | (q3[c2] & 0xffff0000u);
                    *(u32x2*)(KsT + (chl + 2 * c2) * 72 + l0) = wl; *(u32x2*)(KsT + (chl + 2 * c2 + 1) * 72 + l0) = wh; } } }
        { u32x4 rv[4];
#pragma unroll
          for (int i = 0; i < 4; ++i) rv[i] = *(const u32x4*)(MV + (rowb + tg * 4 + i) * 1024 + h * 256 + vg * 8);
          const unsigned q0[4] = {rv[0].x, rv[0].y, rv[0].z, rv[0].w}, q1[4] = {rv[1].x, rv[1].y, rv[1].z, rv[1].w}, q2[4] = {rv[2].x, rv[2].y, rv[2].z, rv[2].w}, q3[4] = {rv[3].x, rv[3].y, rv[3].z, rv[3].w};
#pragma unroll
          for (int c2 = 0; c2 < 4; ++c2) { u32x2 wl, wh;
              wl.x = (q0[c2] & 0xffffu) | (q1[c2] << 16); wl.y = (q2[c2] & 0xffffu) | (q3[c2] << 16);
              wh.x = (q0[c2] >> 16) | (q1[c2] & 0xffff0000u); wh.y = (q2[c2] >> 16) | (q3[c2] & 0xffff0000u);
              *(u32x2*)(VT + (vg * 8 + 2 * c2) * 72 + tg * 4) = wl; *(u32x2*)(VT + (vg * 8 + 2 * c2 + 1) * 72 + tg * 4) = wh; } }
        if (wid == 0) { const float gb = GB[n * 64 + lane], gu = GU[n * 64 + lane], gcm = GCM[n * 64 + lane];
            const float Mx = fmaxf(m_prev, gcm), ei = __expf(m_prev - Mx); const float Mtot = __shfl(Mx, 63), g_ = __shfl(gb, 63);
            FL[lane] = gu; FL[64 + lane] = Mx; FL[128 + lane] = ei; FL[192 + lane] = __expf(gu - Mtot); FL[256 + lane] = __expf(-(gb + Mx));
            const float dec = __expf(m_prev - Mtot); if (lane == 0) FL[384] = dec; dprod *= dec; m_prev = g_ + Mtot; }
        LBAR();
        { const int idx = tid * 16, d = idx >> 6, s0 = idx & 63; const u32x4 a = *(const u32x4*)(KsT + d * 72 + s0), c = *(const u32x4*)(KsT + d * 72 + s0 + 8);
          const float4 w0 = *(const float4*)(FL + 192 + s0), w1 = *(const float4*)(FL + 192 + s0 + 4), w2 = *(const float4*)(FL + 192 + s0 + 8), w3 = *(const float4*)(FL + 192 + s0 + 12);
          u32x4 oa, oc; oa.x = cvt_pk_bf16(bf_lo(a.x) * w0.x, bf_hi(a.x) * w0.y); oa.y = cvt_pk_bf16(bf_lo(a.y) * w0.z, bf_hi(a.y) * w0.w); oa.z = cvt_pk_bf16(bf_lo(a.z) * w1.x, bf_hi(a.z) * w1.y); oa.w = cvt_pk_bf16(bf_lo(a.w) * w1.z, bf_hi(a.w) * w1.w);
          oc.x = cvt_pk_bf16(bf_lo(c.x) * w2.x, bf_hi(c.x) * w2.y); oc.y = cvt_pk_bf16(bf_lo(c.y) * w2.z, bf_hi(c.y) * w2.w); oc.z = cvt_pk_bf16(bf_lo(c.z) * w3.x, bf_hi(c.z) * w3.y); oc.w = cvt_pk_bf16(bf_lo(c.w) * w3.z, bf_hi(c.w) * w3.w);
          *(u32x4*)(KWT + d * 72 + s0) = oa; *(u32x4*)(KWT + d * 72 + s0 + 8) = oc; }
        if (FULL) {
#pragma unroll
            for (int x = 0; x < 2; ++x) { const int tile = 2 * wid + x, ti = tile >> 2, si = tile & 3;
                f32x4 a4 = (f32x4){0.f, 0.f, 0.f, 0.f};
                if (si <= ti) {
#pragma unroll
                    for (int ks = 0; ks < 4; ++ks) { const bf16x8 a = *(const bf16x8*)(Qs + (ti * 16 + fr) * 136 + ks * 32 + fq * 8); const bf16x8 bb2 = *(const bf16x8*)(Ks + (si * 16 + fr) * 136 + ks * 32 + fq * 8);
                        a4 = __builtin_amdgcn_mfma_f32_16x16x32_bf16(a, bb2, a4, 0, 0, 0); } }
                const int s = si * 16 + fr; const float us = FL[s]; const float4 mx4 = *(const float4*)(FL + 64 + ti * 16 + fq * 4); const float mxa[4] = {mx4.x, mx4.y, mx4.z, mx4.w};
#pragma unroll
                for (int jj = 0; jj < 4; ++jj) { const int t = ti * 16 + fq * 4 + jj; const float e = __expf(us - mxa[jj]); const float pv = (s <= t) ? a4[jj] * e : 0.f;
                    Ps[t * 72 + s] = (bf16_t)(cvt_pk_bf16(pv, 0.f) & 0xffff); } } }
        LBAR();
        const float decay = FL[384];
        u32x4 Cb[2][4];
        if (FULL) {
#pragma unroll
            for (int s = 0; s < 2; ++s)
#pragma unroll
                for (int q = 0; q < 4; ++q) { Cb[s][q].x = cvt_pk_bf16(Cacc[2 * q][s][0], Cacc[2 * q][s][1]); Cb[s][q].y = cvt_pk_bf16(Cacc[2 * q][s][2], Cacc[2 * q][s][3]);
                    Cb[s][q].z = cvt_pk_bf16(Cacc[2 * q + 1][s][0], Cacc[2 * q + 1][s][1]); Cb[s][q].w = cvt_pk_bf16(Cacc[2 * q + 1][s][2], Cacc[2 * q + 1][s][3]); } }
        bf16x8 VTb[2][2];
#pragma unroll
        for (int ks = 0; ks < 2; ++ks) { VTb[0][ks] = *(const bf16x8*)(VT + (cs0 * 16 + fr) * 72 + ks * 32 + fq * 8); VTb[1][ks] = *(const bf16x8*)(VT + (cs1 * 16 + fr) * 72 + ks * 32 + fq * 8); }
        { const float* nv_old = NV + (k & 1) * 128; float* nv_new = NV + ((k + 1) & 1) * 128;
          if (FULL) {
              const int t_ = tid >> 3, part = tid & 7;
              const u32x4 qa = *(const u32x4*)(Qs + t_ * 136 + part * 16), qb = *(const u32x4*)(Qs + t_ * 136 + part * 16 + 8);
              const float4 n0v = *(const float4*)(nv_old + part * 16), n1v = *(const float4*)(nv_old + part * 16 + 4), n2v = *(const float4*)(nv_old + part * 16 + 8), n3v = *(const float4*)(nv_old + part * 16 + 12);
              float qn = bf_lo(qa.x) * n0v.x + bf_hi(qa.x) * n0v.y + bf_lo(qa.y) * n0v.z + bf_hi(qa.y) * n0v.w + bf_lo(qa.z) * n1v.x + bf_hi(qa.z) * n1v.y + bf_lo(qa.w) * n1v.z + bf_hi(qa.w) * n1v.w
                       + bf_lo(qb.x) * n2v.x + bf_hi(qb.x) * n2v.y + bf_lo(qb.y) * n2v.z + bf_hi(qb.y) * n2v.w + bf_lo(qb.z) * n3v.x + bf_hi(qb.z) * n3v.y + bf_lo(qb.w) * n3v.z + bf_hi(qb.w) * n3v.w;
              const u32x4 pr = *(const u32x4*)(Ps + t_ * 72 + part * 8);
              const float rs = bf_lo(pr.x) + bf_hi(pr.x) + bf_lo(pr.y) + bf_hi(pr.y) + bf_lo(pr.z) + bf_hi(pr.z) + bf_lo(pr.w) + bf_hi(pr.w);
              float v = FL[128 + t_] * qn + rs;
              v += __shfl_xor(v, 1); v += __shfl_xor(v, 2); v += __shfl_xor(v, 4);
              if (part == 0) FL[320 + t_] = v; }
          if (tid < 128) {
              float acc = 0.f;
#pragma unroll
              for (int i = 0; i < 8; ++i) { const u32x4 kw = *(const u32x4*)(KWT + tid * 72 + i * 8);
                  acc += bf_lo(kw.x) + bf_hi(kw.x) + bf_lo(kw.y) + bf_hi(kw.y) + bf_lo(kw.z) + bf_hi(kw.z) + bf_lo(kw.w) + bf_hi(kw.w); }
              nreg = nreg * decay + acc; nv_new[tid] = nreg; } }
#pragma unroll
        for (int dt = 0; dt < 8; ++dt) { const bf16x8 a0 = *(const bf16x8*)(KWT + (dt * 16 + fr) * 72 + fq * 8), a1 = *(const bf16x8*)(KWT + (dt * 16 + fr) * 72 + 32 + fq * 8);
#pragma unroll
            for (int s = 0; s < 2; ++s) {
                f32x4 c = Cacc[dt][s] * decay; c = __builtin_amdgcn_mfma_f32_16x16x32_bf16(a0, VTb[s][0], c, 0, 0, 0); c = __builtin_amdgcn_mfma_f32_16x16x32_bf16(a1, VTb[s][1], c, 0, 0, 0); Cacc[dt][s] = c; } }
        LBAR();
        if (FULL) {
#pragma unroll 1
            for (int ti = 0; ti < 4; ++ti) {
                u32x4 aq[4];
#pragma unroll
                for (int q = 0; q < 4; ++q) { const bf16_t* qp = Qs + (ti * 16 + fr) * 136 + q * 32 + fq * 4; const u32x2 a0 = *(const u32x2*)qp, a1 = *(const u32x2*)(qp + 16); aq[q].x = a0.x; aq[q].y = a0.y; aq[q].z = a1.x; aq[q].w = a1.y; }
                const bf16x8 ap0 = *(const bf16x8*)(Ps + (ti * 16 + fr) * 72 + fq * 8), ap1 = *(const bf16x8*)(Ps + (ti * 16 + fr) * 72 + 32 + fq * 8);
                const float4 e4 = *(const float4*)(FL + 128 + ti * 16 + fq * 4), d4 = *(const float4*)(FL + 320 + ti * 16 + fq * 4), b4 = *(const float4*)(FL + 256 + ti * 16 + fq * 4);
                const float rd[4] = {__builtin_amdgcn_rcpf(fmaxf(fabsf(d4.x), b4.x)), __builtin_amdgcn_rcpf(fmaxf(fabsf(d4.y), b4.y)), __builtin_amdgcn_rcpf(fmaxf(fabsf(d4.z), b4.z)), __builtin_amdgcn_rcpf(fmaxf(fabsf(d4.w), b4.w))};
#pragma unroll
                for (int s = 0; s < 2; ++s) { f32x4 nacc = (f32x4){0.f, 0.f, 0.f, 0.f};
#pragma unroll
                    for (int q = 0; q < 4; ++q) nacc = __builtin_amdgcn_mfma_f32_16x16x32_bf16(__builtin_bit_cast(bf16x8, aq[q]), __builtin_bit_cast(bf16x8, Cb[s][q]), nacc, 0, 0, 0);
                    nacc[0] *= e4.x; nacc[1] *= e4.y; nacc[2] *= e4.z; nacc[3] *= e4.w;
                    nacc = __builtin_amdgcn_mfma_f32_16x16x32_bf16(ap0, VTb[s][0], nacc, 0, 0, 0); nacc = __builtin_amdgcn_mfma_f32_16x16x32_bf16(ap1, VTb[s][1], nacc, 0, 0, 0);
                    bf16_t* hp = HU + (rowb + ti * 16 + fq * 4) * 1024 + h * 256 + (s == 0 ? cs0 : cs1) * 16 + fr;
#pragma unroll
                    for (int jj = 0; jj < 4; ++jj) hp[jj * 1024] = (bf16_t)(cvt_pk_bf16(nacc[jj] * rd[jj], 0.f) & 0xffff); } }
            LBAR();
        }
    }
    if (!FULL) {
#pragma unroll
        for (int dt = 0; dt < 8; ++dt)
#pragma unroll
            for (int s = 0; s < 2; ++s) { const int c = (s == 0 ? cs0 : cs1) * 16 + fr;
                *(f32x4*)(LG + ((size_t)unit * 272 + c) * 128 + dt * 16 + fq * 4) = Cacc[dt][s]; }
        if (tid < 128) LG[((size_t)unit * 272 + 256) * 128 + tid] = nreg;
        if (tid == 0) LDp[unit] = dprod;
    }
}
__device__ void mlstm_pass2(const Params& P) {
    const float* LG = (const float*)(P.ws + WS_LG); float* CI = (float*)(P.ws + WS_CI); const float* LDp = (const float*)(P.ws + WS_LD);
    const int gtid = blockIdx.x * 512 + opaque_tid(), gs = gridDim.x * 512;
    for (int task = gtid; task < 16 * 257 * 32; task += gs) { const int d4 = task & 31, c = (task >> 5) % 257, bh = task / (257 * 32);
        f32x4 L[16]; float D[16];
#pragma unroll
        for (int g = 0; g < 16; ++g) { L[g] = *(const f32x4*)(LG + ((size_t)(bh * 16 + g) * 272 + c) * 128 + d4 * 4); D[g] = LDp[bh * 16 + g]; }
        f32x4 C = (f32x4){0.f, 0.f, 0.f, 0.f};
#pragma unroll
        for (int g = 0; g < 16; ++g) { *(f32x4*)(CI + ((size_t)(bh * 16 + g) * 272 + c) * 128 + d4 * 4) = C; C = C * D[g] + L[g]; }
    }
}
__device__ void finalize_phase(const Params& P) {
    const int tid = threadIdx.x, lane = tid & 63, wid = tid >> 6;
    const bf16_t* HU = (const bf16_t*)(P.ws + WS_HU); const bf16_t* MO = (const bf16_t*)(P.ws + WS_Z) + PL_MO * PLANE; bf16_t* HM = (bf16_t*)(P.ws + WS_HM);
    const float* LSE = (const float*)(P.ws + WS_LSE); const bf16_t* OP = (const bf16_t*)P.out; bf16_t* HA = (bf16_t*)(P.ws + WS_HA);
    float gn[16];
#pragma unroll
    for (int e = 0; e < 16; ++e) gn[e] = P.m_out_norm[lane * 16 + e];
    for (int row = blockIdx.x * 8 + wid; row < T_; row += gridDim.x * 8) {
        const int hd = lane >> 3, d0 = (lane & 7) * 16; const size_t ro = ((size_t)row * 8 + hd) * 4;
        const float4 ls = *(const float4*)(LSE + ro);
        u32x4 pa[4], pq[4];
#pragma unroll
        for (int s = 0; s < 4; ++s) { const bf16_t* op = OP + (ro + s) * 128 + d0; pa[s] = *(const u32x4*)op; pq[s] = *(const u32x4*)(op + 8); }
        { const size_t off = (size_t)row * 1024 + lane * 16;
          const u32x4 a = *(const u32x4*)(HU + off), bq = *(const u32x4*)(HU + off + 8); const u32x4 ma = *(const u32x4*)(MO + off), mb = *(const u32x4*)(MO + off + 8);
          float v[16] = {bf_lo(a.x), bf_hi(a.x), bf_lo(a.y), bf_hi(a.y), bf_lo(a.z), bf_hi(a.z), bf_lo(a.w), bf_hi(a.w), bf_lo(bq.x), bf_hi(bq.x), bf_lo(bq.y), bf_hi(bq.y), bf_lo(bq.z), bf_hi(bq.z), bf_lo(bq.w), bf_hi(bq.w)};
          const float mo[16] = {bf_lo(ma.x), bf_hi(ma.x), bf_lo(ma.y), bf_hi(ma.y), bf_lo(ma.z), bf_hi(ma.z), bf_lo(ma.w), bf_hi(ma.w), bf_lo(mb.x), bf_hi(mb.x), bf_lo(mb.y), bf_hi(mb.y), bf_lo(mb.z), bf_hi(mb.z), bf_lo(mb.w), bf_hi(mb.w)};
          float ss = 0.f;
#pragma unroll
          for (int e = 0; e < 16; ++e) ss += v[e] * v[e];
          ss += __shfl_xor(ss, 1); ss += __shfl_xor(ss, 2); ss += __shfl_xor(ss, 4); ss += __shfl_xor(ss, 8);
          const float rinv = rsqrtf(ss * (1.0f / 256.0f) + EPS_);
#pragma unroll
          for (int e = 0; e < 16; ++e) v[e] = v[e] * rinv * gn[e] * sigm(mo[e]);
          u32x4 o0, o1; o0.x = cvt_pk_bf16(v[0], v[1]); o0.y = cvt_pk_bf16(v[2], v[3]); o0.z = cvt_pk_bf16(v[4], v[5]); o0.w = cvt_pk_bf16(v[6], v[7]);
          o1.x = cvt_pk_bf16(v[8], v[9]); o1.y = cvt_pk_bf16(v[10], v[11]); o1.z = cvt_pk_bf16(v[12], v[13]); o1.w = cvt_pk_bf16(v[14], v[15]);
          *(u32x4*)(HM + off) = o0; *(u32x4*)(HM + off + 8) = o1; }
        { const int cblk = (row & (SEQ_ - 1)) >> 8; const int nv = cblk < 3 ? cblk : 3;
          const float l0 = nv > 0 ? ls.x : -INFINITY, l1 = nv > 1 ? ls.y : -INFINITY, l2 = nv > 2 ? ls.z : -INFINITY, l3 = ls.w;
          const float M = fmaxf(fmaxf(l0, l1), fmaxf(l2, l3));
          float w[4] = {nv > 0 ? __builtin_amdgcn_exp2f(l0 - M) : 0.f, nv > 1 ? __builtin_amdgcn_exp2f(l1 - M) : 0.f, nv > 2 ? __builtin_amdgcn_exp2f(l2 - M) : 0.f, __builtin_amdgcn_exp2f(l3 - M)};
          const float inv = 1.0f / (w[0] + w[1] + w[2] + w[3]);
          float acc[16];
#pragma unroll
          for (int e = 0; e < 16; ++e) acc[e] = 0.f;
#pragma unroll
          for (int s = 0; s < 4; ++s) { if (s < 3 && s >= nv) continue; const u32x4 a = pa[s], bq = pq[s]; const float ws_ = w[s] * inv;
              acc[0] += ws_ * bf_lo(a.x); acc[1] += ws_ * bf_hi(a.x); acc[2] += ws_ * bf_lo(a.y); acc[3] += ws_ * bf_hi(a.y); acc[4] += ws_ * bf_lo(a.z); acc[5] += ws_ * bf_hi(a.z); acc[6] += ws_ * bf_lo(a.w); acc[7] += ws_ * bf_hi(a.w);
              acc[8] += ws_ * bf_lo(bq.x); acc[9] += ws_ * bf_hi(bq.x); acc[10] += ws_ * bf_lo(bq.y); acc[11] += ws_ * bf_hi(bq.y); acc[12] += ws_ * bf_lo(bq.z); acc[13] += ws_ * bf_hi(bq.z); acc[14] += ws_ * bf_lo(bq.w); acc[15] += ws_ * bf_hi(bq.w); }
          u32x4 o0, o1; o0.x = cvt_pk_bf16(acc[0], acc[1]); o0.y = cvt_pk_bf16(acc[2], acc[3]); o0.z = cvt_pk_bf16(acc[4], acc[5]); o0.w = cvt_pk_bf16(acc[6], acc[7]);
          o1.x = cvt_pk_bf16(acc[8], acc[9]); o1.y = cvt_pk_bf16(acc[10], acc[11]); o1.z = cvt_pk_bf16(acc[12], acc[13]); o1.w = cvt_pk_bf16(acc[14], acc[15]);
          bf16_t* hp = HA + (size_t)row * 1024 + hd * 128 + d0; *(u32x4*)hp = o0; *(u32x4*)(hp + 8) = o1; }
    }
}

template <class Epi> __device__ __forceinline__ void run_gemm(unsigned char* lds, const bf16_t* A, const bf16_t* Bt, int N, int K, const Epi& E) {
    pg8::Gemm g; g.A = A; g.Bt = Bt; g.M = T_; g.N = N; g.K = K;
    pg8::StaticOrder S; S.init(T_, N, (int)gridDim.x, (int)blockIdx.x);
    pg8::gemm_phase<Epi, pg8::StaticOrder, true, true>((PG8_LAS unsigned char*)lds, g, S, E);
    __syncthreads();
}

#define LAS __attribute__((address_space(3)))
#define XB_TMO      128
#define XB_XCNT(j)  (256  + 64 * (j))
#define XB_XSUB(j)  (1280 + 64 * (j))
#define XB_XGEN(j)  (2304 + 64 * (j))
#define XB_TOP      3328
#define XB_TOPGEN   3392
#define XCD_BAR_WORDS 3456
#define XB_SPIN_CAP (1u << 18)

__device__ __forceinline__ unsigned xb_ld(unsigned* p)              { return __hip_atomic_load(p, __ATOMIC_RELAXED, __HIP_MEMORY_SCOPE_AGENT); }
__device__ __forceinline__ unsigned xb_add(unsigned* p, unsigned v) { return __hip_atomic_fetch_add(p, v, __ATOMIC_RELAXED, __HIP_MEMORY_SCOPE_AGENT); }
__device__ __forceinline__ unsigned xb_xcc_id() { return (unsigned)__builtin_amdgcn_s_getreg((3 << 11) | 20) & 0xFu; }
#define XB_SPIN(cond, bar) do { unsigned _sp = 0; while (cond) { __builtin_amdgcn_s_sleep(1); \
    if ((++_sp & 255u) == 0u) { if (xb_ld(&(bar)[XB_TMO])) break; if (_sp > XB_SPIN_CAP) { atomicAdd(&(bar)[XB_TMO], 1u); break; } } } } while (0)

struct XcdBarrier {
    unsigned* bar; unsigned x;
    volatile LAS unsigned* st;
};

__device__ __forceinline__ XcdBarrier xcd_barrier_post(unsigned* bar, volatile LAS unsigned* st) {
    XcdBarrier b; b.bar = bar; b.x = xb_xcc_id(); b.st = st;
    if (threadIdx.x == 0) (void)xb_add(&bar[XB_XCNT(b.x)], 1u);
    return b;
}
__device__ __forceinline__ void xcd_barrier_complete(unsigned* bar, unsigned x, unsigned& nloc, unsigned& nx) {
    const unsigned G = gridDim.x * gridDim.y * gridDim.z;
    unsigned sum, cnt, mine, sp = 0u;
    for (;;) {
        sum = 0u; cnt = 0u; mine = 0u;
#pragma unroll
        for (unsigned j = 0; j < 16; ++j) { const unsigned c = xb_ld(&bar[XB_XCNT(j)]); sum += c; cnt += (c > 0u) ? 1u : 0u; mine = (j == x) ? c : mine; }
        if (sum == G) break;
        __builtin_amdgcn_s_sleep(1);
        if ((++sp & 255u) == 0u) { if (xb_ld(&bar[XB_TMO])) break; if (sp > XB_SPIN_CAP) { atomicAdd(&bar[XB_TMO], 1u); break; } }
    }
    nloc = mine > 0u ? mine : 1u; nx = cnt > 0u ? cnt : 1u;
}

__device__ __forceinline__ void xcd_barrier(const XcdBarrier& b) {
    asm volatile("s_waitcnt vmcnt(0)" ::: "memory");
    __syncthreads();
    if (threadIdx.x == 0) {
        unsigned* bar = b.bar;
        __builtin_amdgcn_s_waitcnt(0);
        unsigned nloc = b.st[0], nx = b.st[1];
        if (nloc == 0u) { xcd_barrier_complete(bar, b.x, nloc, nx); b.st[0] = nloc; b.st[1] = nx; }
        const unsigned old = xb_add(&bar[XB_XSUB(b.x)], 1u);
        const unsigned gen = old / nloc;
        if (old + 1u == (gen + 1u) * nloc) {
            __builtin_amdgcn_fence(__ATOMIC_RELEASE, "agent");
            asm volatile("s_waitcnt vmcnt(0)" ::: "memory");
            const unsigned og = xb_add(&bar[XB_TOP], 1u);
            const unsigned tg = og / nx;
            if (og + 1u == (tg + 1u) * nx) xb_add(&bar[XB_TOPGEN], 1u);
            else XB_SPIN(xb_ld(&bar[XB_TOPGEN]) == tg, bar);
            __builtin_amdgcn_fence(__ATOMIC_ACQUIRE, "agent");
            xb_add(&bar[XB_XGEN(b.x)], 1u);
            asm volatile("s_waitcnt vmcnt(0)" ::: "memory");
        } else {
            XB_SPIN(xb_ld(&bar[XB_XGEN(b.x)]) == gen, bar);
            __builtin_amdgcn_fence(__ATOMIC_ACQUIRE, "agent");
            asm volatile("s_waitcnt vmcnt(0)" ::: "memory");
        }
    }
    __syncthreads();
}


#define WG_LOCAL_HANDOFF() do { if (threadIdx.x == 0) { __builtin_amdgcn_fence(__ATOMIC_ACQUIRE, "agent"); asm volatile("s_waitcnt vmcnt(0)" ::: "memory"); } __syncthreads(); } while (0)
__global__ void __launch_bounds__(512, 2) mega_fwd(Params P) {
    extern __shared__ __attribute__((aligned(16))) unsigned char lds[];
    cg::grid_group grid = cg::this_grid();
    unsigned char* ws = P.ws;
    bf16_t* Z = (bf16_t*)(ws + WS_Z);
    volatile LAS unsigned* xst = (volatile LAS unsigned*)((LAS unsigned char*)lds + (LDS_BYTES - 64));
    if (threadIdx.x < 4) xst[threadIdx.x] = 0u;
    __syncthreads();
    const XcdBarrier xbar = xcd_barrier_post((unsigned*)(ws + WS_XBAR), xst);
    weights_phase(P, lds);
    rms_phase<0>(P.x, P.attn_norm, (bf16_t*)(ws + WS_XN), nullptr, P, lds);
    misc_prologue(P);
    xcd_barrier(xbar);
    if (gridDim.x == 0x7fffffffu) grid.sync();
    { pg8::EpiB<pg8::EM_Z> E{}; E.O = Z; E.ldc = 1024; E.aux1 = nullptr; E.aux2 = nullptr; E.plane = PLANE;
      run_gemm(lds, (const bf16_t*)(ws + WS_XN), (const bf16_t*)(ws + WS_WIN), NZ, 2048, E); }
    xcd_barrier(xbar);
    moba_prep_phase(P, lds);
    mlstm_prep_phase(P);
    xcd_barrier(xbar);
    for (int u = blockIdx.x; u < 256; u += gridDim.x) mlstm_seg<false>(P, u, lds);
    moba_route_phase(P, lds);
    xcd_barrier(xbar);
    mlstm_pass2(P);
    xcd_barrier(xbar);
    for (int u = blockIdx.x; u < 256; u += gridDim.x) mlstm_seg<true>(P, u, lds);
    { const int G = gridDim.x;
      const int grp = (int)blockIdx.x >> 5;
      const unsigned pk = grp == 0 ? (0u | (21u << 5) | (28u << 10) | (29u << 15)) : grp == 1 ? (1u | (18u << 5) | (22u << 10) | (31u << 15)) : grp == 2 ? (2u | (14u << 5) | (24u << 10) | (25u << 15))
                        : grp == 3 ? (3u | (12u << 5) | (17u << 10) | (30u << 15)) : grp == 4 ? (4u | (11u << 5) | (16u << 10) | (26u << 15)) : grp == 5 ? (5u | (10u << 5) | (19u << 10) | (20u << 15))
                        : grp == 6 ? (6u | (9u << 5) | (13u << 10) | (27u << 15)) : (7u | (8u << 5) | (15u << 10) | (23u << 15));
      for (int it = 0; it * G < 1024; ++it) { int j, bh;
          if (G == 256) { j = (int)((pk >> (5 * it)) & 31u); bh = (int)blockIdx.x & 31; }
          else { const int pos = (it & 1) ? (G - 1 - (int)blockIdx.x) : (int)blockIdx.x; const int u = it * G + pos; if (u >= 1024) continue; j = u >> 5; bh = u & 31; }
          moba_unit(P, bh >> 3, bh & 7, j, lds); } }
    xcd_barrier(xbar);
    finalize_phase(P);
    xcd_barrier(xbar);
    { pg8::EpiB<pg8::EM_TMP> E{}; E.O = (bf16_t*)(ws + WS_TMP); E.ldc = 2048; E.aux1 = Z + PL_GM * PLANE; E.aux2 = nullptr; E.plane = PLANE;
      run_gemm(lds, (const bf16_t*)(ws + WS_HM), (const bf16_t*)(ws + WS_WM), 2048, 1024, E); }
    WG_LOCAL_HANDOFF();
    { pg8::EpiB<pg8::EM_MG> E{}; E.O = (bf16_t*)(ws + WS_MG); E.ldc = 2048; E.aux1 = Z + PL_GA * PLANE; E.aux2 = (const bf16_t*)(ws + WS_TMP); E.plane = PLANE;
      run_gemm(lds, (const bf16_t*)(ws + WS_HA), (const bf16_t*)(ws + WS_WA), 2048, 1024, E); }
    xcd_barrier(xbar);
    { pg8::EpiF<pg8::EF_RES, true, false, true> E{}; E.Ob = (bf16_t*)(ws + WS_X1B); E.res = P.x; E.pp = nullptr; E.ldc = 2048; E.hb = (bf16_t*)(ws + WS_XN); E.gvec = P.mlp_norm; E.rsq = (float*)(ws + WS_RSQ1);
      run_gemm(lds, (const bf16_t*)(ws + WS_MG), (const bf16_t*)(ws + WS_WOUT), 2048, 2048, E); }
    xcd_barrier(xbar);
    { pg8::EpiB<pg8::EM_RELU2> E{}; E.O = (bf16_t*)(ws + WS_U); E.ldc = 8192; E.aux1 = nullptr; E.aux2 = nullptr; E.plane = 0;
      E.rsq_in = (const float*)(ws + WS_RSQ1);
      run_gemm(lds, (const bf16_t*)(ws + WS_XN), (const bf16_t*)(ws + WS_W1), 8192, 2048, E); }
    xcd_barrier(xbar);
    { pg8::EpiF<pg8::EF_RES, true, true, false> E{}; E.O = P.out; E.resb = (const bf16_t*)(ws + WS_X1B); E.pp = nullptr; E.ldc = 2048; E.hb = (bf16_t*)(ws + WS_XN); E.gvec = P.ple_norm; E.rsq = (float*)(ws + WS_RSQ2);
      run_gemm(lds, (const bf16_t*)(ws + WS_U), (const bf16_t*)(ws + WS_W2), 2048, 8192, E); }
    xcd_barrier(xbar);
    { pg8::EpiB<pg8::EM_PLAIN> E{}; E.O = (bf16_t*)(ws + WS_PP); E.ldc = 2048; E.aux1 = nullptr; E.aux2 = nullptr; E.plane = 0;
      run_gemm(lds, (const bf16_t*)(ws + WS_PB), (const bf16_t*)(ws + WS_WP), 2048, 256, E); }
    WG_LOCAL_HANDOFF();
    { pg8::EpiF<pg8::EF_PLE, false> E{}; E.O = P.out; E.res = P.out; E.pp = (const bf16_t*)(ws + WS_PP); E.ldc = 2048; E.rsq_in = (const float*)(ws + WS_RSQ2);
      run_gemm(lds, (const bf16_t*)(ws + WS_XN), (const bf16_t*)(ws + WS_WG), 2048, 2048, E); }
    xcd_barrier(xbar);
    rms_phase<2>(P.out, P.final_norm, nullptr, P.out, P, lds);
}

extern "C" void kernel_launch(void* const* d_in, const int* in_sizes, int n_in, void* d_out, int out_size, void* d_ws, size_t ws_size, hipStream_t stream) {
    static int grid_blocks = 0;
    if (grid_blocks == 0) {
        if (n_in != 19 || out_size != T_ * DM || ws_size < WS_END) { fprintf(stderr, "kernel_launch: unexpected shapes: n_in %d out %d ws %zu (need %zu)\n", n_in, out_size, ws_size, (size_t)WS_END); grid_blocks = -1; return; }
        int dev = 0, cus = 0, per_cu = 0;
        hipGetDevice(&dev); hipDeviceGetAttribute(&cus, hipDeviceAttributeMultiprocessorCount, dev);
        if (hipFuncSetAttribute((const void*)mega_fwd, hipFuncAttributeMaxDynamicSharedMemorySize, LDS_BYTES) != hipSuccess) { fprintf(stderr, "kernel_launch: hipFuncSetAttribute(%d B LDS) failed\n", LDS_BYTES); grid_blocks = -1; return; }
        if (hipOccupancyMaxActiveBlocksPerMultiprocessor(&per_cu, (const void*)mega_fwd, 512, LDS_BYTES) != hipSuccess || per_cu < 1) { fprintf(stderr, "kernel_launch: occupancy query gave %d\n", per_cu); per_cu = 1; }
        (void)hipGetLastError();
        grid_blocks = cus * per_cu;
        fprintf(stderr, "kernel_launch: grid %d (cus %d x %d)\n", grid_blocks, cus, per_cu);
    }
    if (grid_blocks < 0) return;
    Params P{};
    P.x = (const float*)d_in[0]; P.p = (const float*)d_in[1]; P.positions = (const int*)d_in[2]; P.attn_norm = (const float*)d_in[3]; P.w_in = (const float*)d_in[4];
    P.b_if = (const float*)d_in[5]; P.conv_w = (const float*)d_in[6]; P.conv_b = (const float*)d_in[7]; P.m_out_norm = (const float*)d_in[8]; P.w_up_m = (const float*)d_in[9];
    P.w_up_a = (const float*)d_in[10]; P.w_out = (const float*)d_in[11]; P.mlp_norm = (const float*)d_in[12]; P.w_ff1 = (const float*)d_in[13]; P.w_ff2 = (const float*)d_in[14];
    P.ple_norm = (const float*)d_in[15]; P.w_ple_gate = (const float*)d_in[16]; P.w_ple_proj = (const float*)d_in[17]; P.final_norm = (const float*)d_in[18];
    P.out = (float*)d_out; P.ws = (unsigned char*)d_ws;
    if (hipMemsetAsync((unsigned char*)d_ws + WS_XBAR, 0, 16384, stream) != hipSuccess) { fprintf(stderr, "kernel_launch: memset of the barrier words failed\n"); return; }
    void* args[] = {&P};
    hipError_t e = hipLaunchCooperativeKernel((const void*)mega_fwd, dim3(grid_blocks), dim3(512), args, LDS_BYTES, stream);
    if (e != hipSuccess) fprintf(stderr, "kernel_launch: cooperative launch failed: %s (grid %d)\n", hipGetErrorString(e), grid_blocks);
}
```

```cpp
#include <hip/hip_runtime.h>
#include <hip/hip_cooperative_groups.h>
#include <cstdio>
#include <cstdint>
namespace cg = cooperative_groups;
namespace pg8 {
#define PG8_LAS __attribute__((address_space(3)))
typedef unsigned short bf16_t;
typedef short bf16x8 __attribute__((ext_vector_type(8)));
typedef float f32x4 __attribute__((ext_vector_type(4)));
typedef unsigned u32x4 __attribute__((ext_vector_type(4)));
constexpr int BM = 256, BK = 64, HALF = 128, HTB = HALF * BK * 2  , STAGE_BYTES = 8 * HTB, NXCD = 8, WGM = 4;

__host__ __device__ __forceinline__ int lds_byte(int r, int c) { const int st = (r >> 4) * 2 + (c >> 5), rr = r & 15, cc = c & 31, ob = rr * 64 + cc * 2; return st * 1024 + (ob ^ (((ob >> 9) & 1) << 5)); }
__host__ __device__ __forceinline__ void stage_rc(int b, int& R, int& C) { const int st = b / 1024, sb = b % 1024, swz = sb ^ (((sb >> 9) & 1) << 5); R = (st >> 1) * 16 + swz / 64; C = (st & 1) * 32 + (swz % 64) / 2; }
__host__ __device__ __forceinline__ int perm32(int rho) { const int n = rho >> 4, i = rho & 15; return 8 * (i >> 2) + 4 * n + (i & 3); }

struct Unit { int pm, pn; };
struct Gemm { const bf16_t* A; const bf16_t* Bt; int M, N, K; };

struct StaticOrder {
    int nM, nN, nwg, G, c;
    __host__ __device__ void init(int M, int N, int G_, int c_) { nM = M / BM; nN = N / BM; nwg = nM * nN; G = G_; c = c_; }
    __host__ __device__ bool next(int i, Unit& u) const {
        const long L = (long)i * G + c; if (L >= nwg) return false;
        int wgid = (int)L; { const int q = nwg / NXCD, r = nwg % NXCD, xcd = wgid % NXCD, off = wgid / NXCD; wgid = (xcd < r ? xcd * (q + 1) : r * (q + 1) + (xcd - r) * q) + off; }
        const int nig = WGM * nN, gid = wgid / nig, fm = gid * WGM, gsz = (nM - fm) < WGM ? (nM - fm) : WGM;
        u.pm = fm + ((wgid % nig) % gsz); u.pn = (wgid % nig) / gsz; return true;
    }
    __device__ __forceinline__ void a_ready(const Unit&) const {}
    __device__ __forceinline__ void done(const Unit&) const {}
};
__device__ __forceinline__ unsigned cvt_pk_bf16(float lo, float hi) { unsigned r; asm volatile("v_cvt_pk_bf16_f32 %0, %1, %2" : "=v"(r) : "v"(lo), "v"(hi)); return r; }
__device__ __forceinline__ float bf_lo(unsigned w) { return __builtin_bit_cast(float, w << 16); }
__device__ __forceinline__ float bf_hi(unsigned w) { return __builtin_bit_cast(float, w & 0xffff0000u); }
__device__ __forceinline__ float sigm(float x) { return __builtin_amdgcn_rcpf(1.0f + __expf(-x)); }
typedef unsigned u32x2 __attribute__((ext_vector_type(2)));

enum { EM_Z = 0, EM_TMP = 1, EM_MG = 2, EM_RELU2 = 3, EM_PLAIN = 4 };
template <int MODE> struct EpiB {
    static constexpr bool PERM = true, AFTER_DRAIN = false;
    bf16_t* O; int ldc; const bf16_t* aux1; const bf16_t* aux2; size_t plane; const float* rsq_in;
    __device__ __forceinline__ void operator()(const f32x4 (&acc)[2][2][4][2], const Unit& u, int wr, int wc, int fr, int fq) const {
        const int row0 = u.pm * BM + wr * 64 + fr; int colt = u.pn * BM; bf16_t* base = O;
        if (MODE == EM_Z) { const int t = colt >> 10; base += (size_t)t * plane; colt &= 1023; }
        const int col0 = colt + wc * 32 + 8 * fq;
#pragma unroll
        for (int ai = 0; ai < 2; ++ai) {
            u32x4 gg[4][2], tt[4][2]; float rs[4];
#pragma unroll
            for (int m = 0; m < 4; ++m) { const int row = row0 + ai * HALF + m * 16;
                if (MODE == EM_RELU2) rs[m] = rsq_in[row];
#pragma unroll
                for (int bj = 0; bj < 2; ++bj) {
                    if (MODE == EM_TMP || MODE == EM_MG) { const int gc = u.pn * BM + bj * HALF + wc * 32 + 8 * fq;
                        gg[m][bj] = *(const u32x4*)(aux1 + (size_t)(gc >> 10) * plane + (size_t)row * 1024 + (gc & 1023)); }
                    if (MODE == EM_MG) tt[m][bj] = *(const u32x4*)(aux2 + (size_t)row * ldc + col0 + bj * HALF); } }
#pragma unroll
            for (int m = 0; m < 4; ++m) { const size_t ro = (size_t)(row0 + ai * HALF + m * 16) * ldc + col0;
#pragma unroll
                for (int bj = 0; bj < 2; ++bj) { f32x4 v0 = acc[ai][bj][m][0], v1 = acc[ai][bj][m][1];
                    const size_t off = ro + bj * HALF;
                    if (MODE == EM_TMP || MODE == EM_MG) { const u32x4 g = gg[m][bj];
                        float s0 = sigm(bf_lo(g.x)), s1 = sigm(bf_hi(g.x)), s2 = sigm(bf_lo(g.y)), s3 = sigm(bf_hi(g.y));
                        float s4 = sigm(bf_lo(g.z)), s5 = sigm(bf_hi(g.z)), s6 = sigm(bf_lo(g.w)), s7 = sigm(bf_hi(g.w));
                        v0 = (f32x4){v0[0] * s0, v0[1] * s1, v0[2] * s2, v0[3] * s3}; v1 = (f32x4){v1[0] * s4, v1[1] * s5, v1[2] * s6, v1[3] * s7};
                        if (MODE == EM_MG) { const u32x4 t = tt[m][bj];
                            v0 = (f32x4){v0[0] + bf_lo(t.x), v0[1] + bf_hi(t.x), v0[2] + bf_lo(t.y), v0[3] + bf_hi(t.y)};
                            v1 = (f32x4){v1[0] + bf_lo(t.z), v1[1] + bf_hi(t.z), v1[2] + bf_lo(t.w), v1[3] + bf_hi(t.w)}; }
                    }
                    if (MODE == EM_RELU2) { const float rin = rsqrtf(rs[m] * (1.0f / 2048.0f) + 1e-6f);
#pragma unroll
                        for (int j = 0; j < 4; ++j) { float a = fmaxf(v0[j], 0.f) * rin, b = fmaxf(v1[j], 0.f) * rin; v0[j] = a * a; v1[j] = b * b; } }
                    u32x4 w; w.x = cvt_pk_bf16(v0[0], v0[1]); w.y = cvt_pk_bf16(v0[2], v0[3]); w.z = cvt_pk_bf16(v1[0], v1[1]); w.w = cvt_pk_bf16(v1[2], v1[3]);
                    *(u32x4*)(base + off) = w; } } }
    }
};
enum { EF_RES = 0, EF_PLE = 1 };
template <int MODE, bool NORM, bool RESB = false, bool OUTB = false> struct EpiF {
    static constexpr bool PERM = false, AFTER_DRAIN = false;
    float* O; const float* res; const bf16_t* pp; int ldc; bf16_t* hb; const float* gvec; float* rsq; const float* rsq_in; bf16_t* Ob; const bf16_t* resb;
    __device__ __forceinline__ void operator()(const f32x4 (&acc)[2][2][4][2], const Unit& u, int wr, int wc, int fr, int fq) const {
        const int row0 = u.pm * BM + wr * 64 + fr, col0 = u.pn * BM + wc * 32 + 4 * fq;
        f32x4 gv[2][2];
        if (NORM) {
#pragma unroll
            for (int bj = 0; bj < 2; ++bj)
#pragma unroll
                for (int n = 0; n < 2; ++n) gv[bj][n] = *(const f32x4*)(gvec + col0 + bj * HALF + n * 16); }
#pragma unroll
        for (int ai = 0; ai < 2; ++ai)
#pragma unroll
            for (int mh = 0; mh < 2; ++mh) {
                f32x4 rr[2][2][2]; u32x2 qq[2][2][2]; float rin[2] = {1.f, 1.f};
#pragma unroll
                for (int mi = 0; mi < 2; ++mi) { const int row = row0 + ai * HALF + (mh * 2 + mi) * 16; const size_t ro = (size_t)row * ldc + col0;
                    if (MODE == EF_PLE) rin[mi] = rsq_in[row];
#pragma unroll
                    for (int bj = 0; bj < 2; ++bj)
#pragma unroll
                        for (int n = 0; n < 2; ++n) { const size_t off = ro + bj * HALF + n * 16;
                            if (RESB) { const u32x2 t2 = *(const u32x2*)(resb + off); rr[mi][bj][n] = (f32x4){bf_lo(t2.x), bf_hi(t2.x), bf_lo(t2.y), bf_hi(t2.y)}; }
                            else rr[mi][bj][n] = *(const f32x4*)(res + off);
                            if (MODE == EF_PLE) qq[mi][bj][n] = *(const u32x2*)(pp + off); } }
#pragma unroll
                for (int mi = 0; mi < 2; ++mi) { const int m = mh * 2 + mi; const int row = row0 + ai * HALF + m * 16; const size_t ro = (size_t)row * ldc + col0;
                    const float rn = (MODE == EF_PLE) ? rsqrtf(rin[mi] * (1.0f / 2048.0f) + 1e-6f) : 1.f;
                    float ss = 0.f;
#pragma unroll
                    for (int bj = 0; bj < 2; ++bj)
#pragma unroll
                        for (int n = 0; n < 2; ++n) { const size_t off = ro + bj * HALF + n * 16;
                            f32x4 v = acc[ai][bj][m][n];
                            if (MODE == EF_PLE) { const u32x2 q = qq[mi][bj][n];
                                v = (f32x4){sigm(v[0] * rn) * bf_lo(q.x), sigm(v[1] * rn) * bf_hi(q.x), sigm(v[2] * rn) * bf_lo(q.y), sigm(v[3] * rn) * bf_hi(q.y)}; }
                            const f32x4 o = rr[mi][bj][n] + v;
                            if (OUTB) { u32x2 wo; wo.x = cvt_pk_bf16(o[0], o[1]); wo.y = cvt_pk_bf16(o[2], o[3]); *(u32x2*)(Ob + off) = wo; }
                            else *(f32x4*)(O + off) = o;
                            if (NORM) { ss += o[0] * o[0] + o[1] * o[1] + o[2] * o[2] + o[3] * o[3];
                                const f32x4 h = o * gv[bj][n]; u32x2 w; w.x = cvt_pk_bf16(h[0], h[1]); w.y = cvt_pk_bf16(h[2], h[3]); *(u32x2*)(hb + off) = w; } }
                    if (NORM) { ss += __shfl_xor(ss, 16); ss += __shfl_xor(ss, 32); if (fq == 0) atomicAdd(rsq + row, ss); } } }
    }
};
template <class Epi, class Sched, bool ALIGN_EPI = false, bool SP2 = false>
__device__ __forceinline__ void gemm_phase(PG8_LAS unsigned char* lds, const Gemm g, const Sched& S, const Epi& E) {
    int tid_ = threadIdx.x; asm volatile("" : "+v"(tid_));
    const int tid = tid_, wid = __builtin_amdgcn_readfirstlane(tid >> 6), lane = tid & 63, wr = wid >> 2, wc = wid & 3, fr = lane & 15, fq = lane >> 4;
    int K_ = g.K; asm volatile("" : "+s"(K_)); const int K = K_, nt = K / BK;
    unsigned voffA[2], voffB[2];
#pragma unroll
    for (int i = 0; i < 2; ++i) { int R, C; stage_rc(tid * 16 + i * 8192, R, C); const int Rb = Epi::PERM ? ((R & ~31) + perm32(R & 31)) : R;
        voffA[i] = (unsigned)(R * K + C) * 2u; voffB[i] = (unsigned)(Rb * K + C) * 2u; }
    const size_t kstep = (size_t)(BK * 2);
    const size_t hstep = (size_t)HALF * K * 2;
    const size_t tstep = 2 * hstep;
    const unsigned ldsw = (unsigned)wid * 1024u;
    const int aoff = lds_byte(wr * 64 + fr, fq * 8), boff = lds_byte(wc * 32 + fr, fq * 8);
#define PG8_SA(b, h) (((b) * 2 + (h)) * HTB)
#define PG8_SB(b, h) ((4 + (b) * 2 + (h)) * HTB)
#define PG8_STAGE(bufoff, gbase, voff) do { _Pragma("unroll") for (int _i = 0; _i < 2; ++_i) \
        __builtin_amdgcn_global_load_lds((const unsigned*)((const char*)(gbase) + (voff)[_i]), (PG8_LAS unsigned*)(lds + (bufoff) + ldsw + _i * 8192), 16, 0, 0); } while (0)
#define PG8_LDA(dst, b, h) do { _Pragma("unroll") for (int m = 0; m < 4; ++m) _Pragma("unroll") for (int k = 0; k < 2; ++k) dst[m][k] = *(const PG8_LAS bf16x8*)(lds + PG8_SA(b, h) + aoff + m * 2048 + k * 1024); } while (0)
#define PG8_LDB(dst, b, h) do { _Pragma("unroll") for (int n = 0; n < 2; ++n) _Pragma("unroll") for (int k = 0; k < 2; ++k) dst[n][k] = *(const PG8_LAS bf16x8*)(lds + PG8_SB(b, h) + boff + n * 2048 + k * 1024); } while (0)
#define PG8_MMA(ai, bj, At, Bt) do { __builtin_amdgcn_s_setprio(1); _Pragma("unroll") for (int m = 0; m < 4; ++m) _Pragma("unroll") for (int n = 0; n < 2; ++n) _Pragma("unroll") for (int k = 0; k < 2; ++k) \
        acc[ai][bj][m][n] = __builtin_amdgcn_mfma_f32_16x16x32_bf16(Bt[n][k], At[m][k], acc[ai][bj][m][n], 0, 0, 0); __builtin_amdgcn_s_setprio(0); } while (0)
#define PG8_WAIT_V(n) asm volatile("s_waitcnt vmcnt(" #n ")" ::: "memory")
#define PG8_WAIT_L(n) asm volatile("s_waitcnt lgkmcnt(" #n ")" ::: "memory")
#define PG8_BAR __builtin_amdgcn_s_barrier()
#define PG8_SCHED __builtin_amdgcn_sched_barrier(0)
    Unit cur, nxt; int ui = 0;
    if (!S.next(0, cur)) return;
    f32x4 acc[2][2][4][2];
#pragma unroll
    for (int a = 0; a < 2; ++a)
#pragma unroll
        for (int b = 0; b < 2; ++b)
#pragma unroll
            for (int m = 0; m < 4; ++m)
#pragma unroll
                for (int n = 0; n < 2; ++n) acc[a][b][m][n] = (f32x4){0.f, 0.f, 0.f, 0.f};
    bf16x8 At[4][2], B0[2][2], B1[2][2];
    const char* cA = (const char*)g.A + (size_t)cur.pm * tstep; const char* cB = (const char*)g.Bt + (size_t)cur.pn * tstep;
    S.a_ready(cur);
    if constexpr (SP2) {
        PG8_STAGE(PG8_SB(0, 0), cB, voffB); PG8_STAGE(PG8_SB(0, 1), cB + hstep, voffB); PG8_STAGE(PG8_SA(0, 0), cA, voffA); PG8_STAGE(PG8_SA(0, 1), cA + hstep, voffA);
        if (wr == 1) PG8_BAR;
        PG8_WAIT_V(2); PG8_BAR;
        PG8_STAGE(PG8_SB(1, 0), cB + kstep, voffB); PG8_STAGE(PG8_SA(1, 0), cA + kstep, voffA); PG8_STAGE(PG8_SB(1, 1), cB + hstep + kstep, voffB);
        PG8_WAIT_V(6); PG8_BAR;
    } else {
        PG8_STAGE(PG8_SB(0, 0), cB, voffB); PG8_STAGE(PG8_SA(0, 0), cA, voffA); PG8_STAGE(PG8_SB(0, 1), cB + hstep, voffB); PG8_STAGE(PG8_SA(0, 1), cA + hstep, voffA);
        if (wr == 1) PG8_BAR;
        PG8_WAIT_V(4); PG8_BAR;
        PG8_STAGE(PG8_SB(1, 0), cB + kstep, voffB); PG8_STAGE(PG8_SA(1, 0), cA + kstep, voffA); PG8_STAGE(PG8_SB(1, 1), cB + hstep + kstep, voffB);
        PG8_WAIT_V(6); PG8_BAR;
    }
    for (;;) {
        const bool has_next = S.next(ui + 1, nxt);
        const char* nA = has_next ? (const char*)g.A + (size_t)nxt.pm * tstep : cA; const char* nB = has_next ? (const char*)g.Bt + (size_t)nxt.pn * tstep : cB;
        for (int t = 0; t < nt; t += 2) {
            const bool last = (t == nt - 2);
            const char* a1 = cA + (size_t)(t + 1) * kstep;
            const char* a2 = last ? nA : cA + (size_t)(t + 2) * kstep; const char* b2 = last ? nB : cB + (size_t)(t + 2) * kstep;
            const char* a3 = a2 + kstep; const char* b3 = b2 + kstep;
            if (last && has_next) S.a_ready(nxt);
            if constexpr (SP2) {
            PG8_LDB(B0, 0, 0); PG8_LDB(B1, 0, 1); PG8_SCHED; PG8_LDA(At, 0, 0); PG8_STAGE(PG8_SA(1, 1), a1 + hstep, voffA);
            PG8_WAIT_V(8); PG8_WAIT_L(0); PG8_BAR; PG8_MMA(0, 0, At, B0); PG8_MMA(0, 1, At, B1); PG8_BAR; PG8_SCHED;
            PG8_LDA(At, 0, 1); PG8_STAGE(PG8_SB(0, 0), b2, voffB); PG8_STAGE(PG8_SB(0, 1), b2 + hstep, voffB); PG8_STAGE(PG8_SA(0, 0), a2, voffA);
            PG8_WAIT_V(8); PG8_WAIT_L(0); PG8_BAR; PG8_MMA(1, 0, At, B0); PG8_MMA(1, 1, At, B1); PG8_BAR; PG8_SCHED;
            PG8_LDB(B0, 1, 0); PG8_LDB(B1, 1, 1); PG8_SCHED; PG8_LDA(At, 1, 0); PG8_STAGE(PG8_SA(0, 1), a2 + hstep, voffA);
            PG8_WAIT_V(8); PG8_WAIT_L(0); PG8_BAR; PG8_MMA(0, 0, At, B0); PG8_MMA(0, 1, At, B1); PG8_BAR; PG8_SCHED;
            PG8_LDA(At, 1, 1); PG8_STAGE(PG8_SB(1, 0), b3, voffB); PG8_STAGE(PG8_SB(1, 1), b3 + hstep, voffB); PG8_STAGE(PG8_SA(1, 0), a3, voffA);
            PG8_WAIT_V(8); PG8_WAIT_L(0); PG8_BAR; PG8_MMA(1, 0, At, B0); PG8_MMA(1, 1, At, B1); PG8_BAR; PG8_SCHED;
            } else {
            PG8_LDB(B0, 0, 0); PG8_SCHED; PG8_LDA(At, 0, 0); PG8_STAGE(PG8_SA(1, 1), a1 + hstep, voffA);
            PG8_WAIT_L(8); PG8_BAR; PG8_WAIT_L(0); PG8_MMA(0, 0, At, B0); PG8_BAR; PG8_SCHED;
            PG8_LDB(B1, 0, 1); PG8_STAGE(PG8_SB(0, 0), b2, voffB);
            PG8_BAR; PG8_WAIT_L(0); PG8_MMA(0, 1, At, B1); PG8_BAR;
            PG8_LDA(At, 0, 1); PG8_STAGE(PG8_SA(0, 0), a2, voffA);
            PG8_BAR; PG8_WAIT_L(0); PG8_MMA(1, 0, At, B0); PG8_BAR; PG8_SCHED;
            PG8_STAGE(PG8_SB(0, 1), b2 + hstep, voffB);
            PG8_WAIT_V(6); PG8_BAR; PG8_MMA(1, 1, At, B1); PG8_BAR;
            PG8_LDB(B0, 1, 0); PG8_SCHED; PG8_LDA(At, 1, 0); PG8_STAGE(PG8_SA(0, 1), a2 + hstep, voffA);
            PG8_WAIT_L(8); PG8_BAR; PG8_WAIT_L(0); PG8_MMA(0, 0, At, B0); PG8_BAR; PG8_SCHED;
            PG8_LDB(B1, 1, 1); PG8_STAGE(PG8_SB(1, 0), b3, voffB);
            PG8_BAR; PG8_WAIT_L(0); PG8_MMA(0, 1, At, B1); PG8_BAR;
            PG8_LDA(At, 1, 1); PG8_STAGE(PG8_SA(1, 0), a3, voffA);
            PG8_BAR; PG8_WAIT_L(0); PG8_MMA(1, 0, At, B0); PG8_BAR; PG8_SCHED;
            PG8_STAGE(PG8_SB(1, 1), b3 + hstep, voffB);
            PG8_WAIT_V(6); PG8_BAR; PG8_MMA(1, 1, At, B1); PG8_BAR;
            }
        }
        if constexpr (ALIGN_EPI) { if (wr == 0) PG8_BAR; }
        if constexpr (!Epi::AFTER_DRAIN) { E(acc, cur, wr, wc, fr, fq); S.done(cur); }
        if (!has_next) break;
#pragma unroll
        for (int a = 0; a < 2; ++a)
#pragma unroll
            for (int b = 0; b < 2; ++b)
#pragma unroll
                for (int m = 0; m < 4; ++m)
#pragma unroll
                    for (int n = 0; n < 2; ++n) acc[a][b][m][n] = (f32x4){0.f, 0.f, 0.f, 0.f};
        cur = nxt; cA = nA; cB = nB; ++ui;
        if constexpr (ALIGN_EPI) { if (wr == 1) PG8_BAR; }
    }
    PG8_WAIT_V(0);
    if constexpr (!ALIGN_EPI) { if (wr == 0) PG8_BAR; }
    PG8_BAR;
    if constexpr (Epi::AFTER_DRAIN) { E.fused(acc, cur, wr, wc, fr, fq, lds, wid, lane); S.done(cur); }
#undef PG8_SA
#undef PG8_SB
#undef PG8_STAGE
#undef PG8_LDA
#undef PG8_LDB
#undef PG8_MMA
#undef PG8_WAIT_V
#undef PG8_WAIT_L
#undef PG8_BAR
#undef PG8_SCHED
}
}

typedef unsigned short bf16_t;
typedef short bf16x8 __attribute__((ext_vector_type(8)));
typedef float f32x4 __attribute__((ext_vector_type(4)));
typedef unsigned u32x4 __attribute__((ext_vector_type(4)));
typedef unsigned u32x2 __attribute__((ext_vector_type(2)));
using pg8::cvt_pk_bf16; using pg8::bf_lo; using pg8::bf_hi; using pg8::sigm;

constexpr int NB_ = 4, SEQ_ = 8192, T_ = NB_ * SEQ_, DM = 2048, DFF = 8192, INW = 10248, NZ = 10240;
constexpr float EPS_ = 1e-6f;
constexpr size_t MiB = 1u << 20;
constexpr size_t WS_RSQ1 = 0, WS_RSQ2 = (size_t)T_ * 4, WS_XBAR = 512 * 1024;
constexpr size_t WS_IF = 1 * MiB, WS_CS = 2 * MiB, WS_KM = 6 * MiB, WS_SEL = 7 * MiB, WS_LSE = 8 * MiB, WS_PB = 12 * MiB;
constexpr size_t WS_WIN = 28 * MiB, WS_WM = 68 * MiB, WS_WA = 72 * MiB, WS_WOUT = 76 * MiB, WS_W1 = 84 * MiB, WS_W2 = 116 * MiB, WS_WG = 148 * MiB, WS_WP = 156 * MiB;
constexpr size_t WS_XN = 160 * MiB, WS_HM = 160 * MiB, WS_HU = 224 * MiB, WS_QKC = 160 * MiB;
constexpr size_t WS_Z = 288 * MiB, PLANE = (size_t)T_ * 1024;
constexpr size_t WS_X1B = WS_Z + 512 * MiB;
constexpr size_t WS_HA = WS_Z, WS_TMP = WS_Z + 64 * MiB, WS_MG = WS_Z + 192 * MiB, WS_U = WS_Z, WS_PP = WS_Z + 512 * MiB;
constexpr size_t WS_GB = 928 * MiB, WS_GU = WS_GB + 512 * 1024, WS_GCM = WS_GU + 512 * 1024;
constexpr size_t WS_DUMP = 930 * MiB;
constexpr size_t WS_LG = 931 * MiB, WS_CI = 965 * MiB, WS_LD = 999 * MiB;
constexpr size_t WS_END = 1000 * MiB;
constexpr int LDS_BYTES = 163840;
enum { PL_QK = 0, PL_MV = 1, PL_MO = 2, PL_AQ = 3, PL_AK = 4, PL_AV = 5, PL_GM = 6, PL_GA = 8 };

struct Params {
    const float* x; const float* p; const int* positions; const float* attn_norm; const float* w_in; const float* b_if; const float* conv_w; const float* conv_b;
    const float* m_out_norm; const float* w_up_m; const float* w_up_a; const float* w_out; const float* mlp_norm; const float* w_ff1; const float* w_ff2;
    const float* ple_norm; const float* w_ple_gate; const float* w_ple_proj; const float* final_norm;
    float* out; unsigned char* ws;
};

__device__ __forceinline__ int opaque_tid() { int t_ = threadIdx.x; asm volatile("" : "+v"(t_)); return t_; }
__device__ __forceinline__ float wave_sum(float v) {
#pragma unroll
    for (int o = 32; o > 0; o >>= 1) v += __shfl_xor(v, o);
    return v;
}

#define LBAR() do { asm volatile("s_waitcnt lgkmcnt(0)" ::: "memory"); __builtin_amdgcn_s_barrier(); asm volatile("" ::: "memory"); } while (0)
template <int K, int N, int LDS_, bool WIN> __device__ __forceinline__ void wmat(const float* src, bf16_t* dst, int base, unsigned char* lds) {
    const int tid = threadIdx.x; constexpr int LD = 260, nN = N / 256, NT = nN * (K / 64);
    float* tl0 = (float*)lds; float* tl1 = tl0 + 64 * LD;
    const int G = gridDim.x; int t = ((int)blockIdx.x - base % G + G) % G;
    float4 r0, r1, r2, r3, r4, r5, r6, r7;
#define WLOAD(tt_) do { const int k0_ = ((tt_) / nN) * 64, n0_ = ((tt_) % nN) * 256; const float* b_ = src + (size_t)(k0_ + (tid >> 6)) * LDS_ + ((WIN && n0_ >= 3072) ? 8 : 0) + n0_ + (tid & 63) * 4; constexpr size_t st_ = (size_t)8 * LDS_; \
        r0 = *(const float4*)b_; r1 = *(const float4*)(b_ + st_); r2 = *(const float4*)(b_ + 2 * st_); r3 = *(const float4*)(b_ + 3 * st_); \
        r4 = *(const float4*)(b_ + 4 * st_); r5 = *(const float4*)(b_ + 5 * st_); r6 = *(const float4*)(b_ + 6 * st_); r7 = *(const float4*)(b_ + 7 * st_); } while (0)
    if (t < NT) WLOAD(t);
    int par = 0;
    for (; t < NT; t += G) {
        float* tl = par ? tl1 : tl0;
        { float* wp = tl + (tid >> 6) * LD + (tid & 63) * 4;
          *(float4*)wp = r0; *(float4*)(wp + 8 * LD) = r1; *(float4*)(wp + 16 * LD) = r2; *(float4*)(wp + 24 * LD) = r3;
          *(float4*)(wp + 32 * LD) = r4; *(float4*)(wp + 40 * LD) = r5; *(float4*)(wp + 48 * LD) = r6; *(float4*)(wp + 56 * LD) = r7; }
        if (t + G < NT) WLOAD(t + G);
        LBAR();
        { const int nn = tid & 255, k0 = (t / nN) * 64, n0 = (t % nN) * 256;
#pragma unroll
          for (int i = 0; i < 4; ++i) { const int k8 = ((tid >> 8) + 2 * i) * 8; const float* rp = tl + k8 * LD + nn;
              u32x4 w; w.x = cvt_pk_bf16(rp[0], rp[LD]); w.y = cvt_pk_bf16(rp[2 * LD], rp[3 * LD]); w.z = cvt_pk_bf16(rp[4 * LD], rp[5 * LD]); w.w = cvt_pk_bf16(rp[6 * LD], rp[7 * LD]);
              *(u32x4*)(dst + (size_t)(n0 + nn) * K + k0 + k8) = w; } }
        par ^= 1;
    }
#undef WLOAD
    __syncthreads();
}
__device__ void weights_phase(const Params& P, unsigned char* lds) {
    unsigned char* ws = P.ws;
    wmat<2048, NZ, INW, true>(P.w_in, (bf16_t*)(ws + WS_WIN), 0, lds);
    wmat<2048, 8192, 8192, false>(P.w_ff1, (bf16_t*)(ws + WS_W1), 1280, lds);
    wmat<8192, 2048, 2048, false>(P.w_ff2, (bf16_t*)(ws + WS_W2), 2304, lds);
    wmat<2048, 2048, 2048, false>(P.w_out, (bf16_t*)(ws + WS_WOUT), 3328, lds);
    wmat<2048, 2048, 2048, false>(P.w_ple_gate, (bf16_t*)(ws + WS_WG), 3584, lds);
    wmat<1024, 2048, 2048, false>(P.w_up_m, (bf16_t*)(ws + WS_WM), 3840, lds);
    wmat<1024, 2048, 2048, false>(P.w_up_a, (bf16_t*)(ws + WS_WA), 3968, lds);
    wmat<256, 2048, 2048, false>(P.w_ple_proj, (bf16_t*)(ws + WS_WP), 4096, lds);
}
template <int MODE> __device__ void rms_phase(const float* X, const float* g, bf16_t* ob, float* of, const Params& P, unsigned char* lds) {
    const int tid = threadIdx.x, lane = tid & 63, wid = tid >> 6;
    float* wg = (float*)lds;
    if (MODE == 0) {
        for (int i = tid; i < 8 * 2048; i += 512) { const int c = i & 7, k = i >> 3; wg[c * 2048 + k] = P.w_in[(size_t)k * INW + 3072 + c]; }
        __syncthreads();
    }
    float4 gv[8];
#pragma unroll
    for (int j = 0; j < 8; ++j) gv[j] = *(const float4*)(g + j * 256 + lane * 4);
    const int rstep = gridDim.x * 8; float4 nvv[8];
    { const int r0_ = blockIdx.x * 8 + wid;
      if (r0_ < T_) {
#pragma unroll
          for (int j = 0; j < 8; ++j) nvv[j] = *(const float4*)(X + (size_t)r0_ * DM + j * 256 + lane * 4); } }
    for (int row = blockIdx.x * 8 + wid; row < T_; row += rstep) {
        float4 v[8]; float ss = 0.f;
#pragma unroll
        for (int j = 0; j < 8; ++j) { v[j] = nvv[j]; ss += v[j].x * v[j].x + v[j].y * v[j].y + v[j].z * v[j].z + v[j].w * v[j].w; }
        if (row + rstep < T_) {
#pragma unroll
            for (int j = 0; j < 8; ++j) nvv[j] = *(const float4*)(X + (size_t)(row + rstep) * DM + j * 256 + lane * 4); }
        ss = wave_sum(ss);
        const float rinv = rsqrtf(ss * (1.0f / DM) + EPS_);
#pragma unroll
        for (int j = 0; j < 8; ++j) { v[j].x = v[j].x * rinv * gv[j].x; v[j].y = v[j].y * rinv * gv[j].y; v[j].z = v[j].z * rinv * gv[j].z; v[j].w = v[j].w * rinv * gv[j].w; }
        if (MODE == 2) {
#pragma unroll
            for (int j = 0; j < 8; ++j) *(float4*)(of + (size_t)row * DM + j * 256 + lane * 4) = v[j];
        } else {
#pragma unroll
            for (int j = 0; j < 8; ++j) { u32x2 w; w.x = cvt_pk_bf16(v[j].x, v[j].y); w.y = cvt_pk_bf16(v[j].z, v[j].w); *(u32x2*)(ob + (size_t)row * DM + j * 256 + lane * 4) = w; }
        }
        if (MODE == 0) {
            float a[8];
#pragma unroll
            for (int c = 0; c < 8; ++c) { float s = 0.f;
#pragma unroll
                for (int j = 0; j < 8; ++j) { const float4 w = *(const float4*)(wg + c * 2048 + j * 256 + lane * 4); s += v[j].x * w.x + v[j].y * w.y + v[j].z * w.z + v[j].w * w.w; }
                a[c] = wave_sum(s); }
            if (lane < 8) { float s = a[0];
#pragma unroll
                for (int c = 1; c < 8; ++c) s = (lane == c) ? a[c] : s;
                ((float*)(P.ws + WS_IF))[(size_t)row * 8 + lane] = s + P.b_if[lane]; }
        }
    }
}
__device__ void misc_prologue(const Params& P) {
    const size_t gt = (size_t)blockIdx.x * 512 + threadIdx.x, gs = (size_t)gridDim.x * 512;
    { float* z = (float*)(P.ws + WS_RSQ1); for (size_t i = gt; i < (size_t)2 * T_; i += gs) z[i] = 0.f; }
    bf16_t* pb = (bf16_t*)(P.ws + WS_PB);
    for (size_t i = gt; i < (size_t)T_ * 256 / 4; i += gs) { const float4 v = *(const float4*)(P.p + i * 4); u32x2 w; w.x = cvt_pk_bf16(v.x, v.y); w.y = cvt_pk_bf16(v.z, v.w); *(u32x2*)(pb + i * 4) = w; }
    float2* cs = (float2*)(P.ws + WS_CS);
    for (size_t i = gt; i < (size_t)T_ * 16; i += gs) { const int t = (int)(i >> 4), f = (int)(i & 15);
        const float invf = (float)pow(500000.0, -(double)f / 16.0); const float ang = (float)P.positions[t] * invf;
        float s, c; sincosf(ang, &s, &c); cs[i] = make_float2(c, s); }
}

__device__ void moba_prep_phase(const Params& P, unsigned char* lds) {
    const int tid = threadIdx.x, rr = tid >> 4, ch = tid & 15;
    float* red = (float*)lds;
    bf16_t* AQ = (bf16_t*)(P.ws + WS_Z) + PL_AQ * PLANE; bf16_t* AK = (bf16_t*)(P.ws + WS_Z) + PL_AK * PLANE;
    const float2* cs = (const float2*)(P.ws + WS_CS); float* KM = (float*)(P.ws + WS_KM);
    for (int u = blockIdx.x; u < 1024; u += gridDim.x) {
        const int b = u >> 8, j = (u >> 3) & 31, h = u & 7; const int r0 = b * SEQ_ + j * 256;
        float ks[8];
#pragma unroll
        for (int e = 0; e < 8; ++e) ks[e] = 0.f;
        for (int pb = 0; pb < 4; ++pb) {
            u32x4 wq[2], wk[2]; float4 cv[2][4]; size_t offs[2];
#pragma unroll
            for (int i = 0; i < 2; ++i) { const int row = r0 + (pb * 2 + i) * 32 + rr; offs[i] = (size_t)row * 1024 + h * 128 + ch * 8;
                wq[i] = *(const u32x4*)(AQ + offs[i]); wk[i] = *(const u32x4*)(AK + offs[i]);
                if (ch < 4) { const float4* cp = (const float4*)(cs + (size_t)row * 16 + (ch & 1) * 8);
#pragma unroll
                    for (int q4 = 0; q4 < 4; ++q4) cv[i][q4] = cp[q4]; }
                else {
#pragma unroll
                    for (int q4 = 0; q4 < 4; ++q4) cv[i][q4] = make_float4(1.f, 0.f, 1.f, 0.f); } }
#pragma unroll
            for (int i = 0; i < 2; ++i) {
#pragma unroll
                for (int which = 0; which < 2; ++which) { bf16_t* pl = which ? AK : AQ; const u32x4 w = which ? wk[i] : wq[i];
                    float x[8] = {bf_lo(w.x), bf_hi(w.x), bf_lo(w.y), bf_hi(w.y), bf_lo(w.z), bf_hi(w.z), bf_lo(w.w), bf_hi(w.w)};
                    float y[8];
#pragma unroll
                    for (int e = 0; e < 8; ++e) { const float o = __shfl_xor(x[e], 2);
                        const float4 c4 = cv[i][e >> 1]; const float cc = (e & 1) ? c4.z : c4.x, sn = (e & 1) ? c4.w : c4.y;
                        y[e] = (ch < 2) ? (x[e] * cc - o * sn) : (x[e] * cc + o * sn); }
                    if (which == 0) {
#pragma unroll
                        for (int e = 0; e < 8; ++e) y[e] *= 0.12751743074602468f;
                    } else {
#pragma unroll
                        for (int e = 0; e < 8; ++e) ks[e] += y[e];
                    }
                    u32x4 o; o.x = cvt_pk_bf16(y[0], y[1]); o.y = cvt_pk_bf16(y[2], y[3]); o.z = cvt_pk_bf16(y[4], y[5]); o.w = cvt_pk_bf16(y[6], y[7]);
                    *(u32x4*)(pl + offs[i]) = o; } } }
#pragma unroll
        for (int e = 0; e < 8; ++e) red[rr * 128 + ch * 8 + e] = ks[e];
        __syncthreads();
        if (tid < 128) { float s = 0.f;
            for (int r = 0; r < 32; ++r) s += red[r * 128 + tid];
            KM[((size_t)((b * 8 + h) * 32 + j)) * 128 + tid] = s * (1.0f / 256.0f); }
        __syncthreads();
    }
}
__device__ void moba_route_phase(const Params& P, unsigned char* lds) {
    const int tid = threadIdx.x, lane = tid & 63, wid = tid >> 6, fr = lane & 15, fq = lane >> 4;
    bf16_t* kmh = (bf16_t*)lds;
    bf16_t* kml = kmh + 32 * 136;
    float* sc = (float*)(lds + 32768);
    const bf16_t* AQ = (const bf16_t*)(P.ws + WS_Z) + PL_AQ * PLANE; const float* KM = (const float*)(P.ws + WS_KM); unsigned* SEL = (unsigned*)(P.ws + WS_SEL);
    for (int u = blockIdx.x; u < 1024; u += gridDim.x) {
        const int bh = u & 31, c = u >> 5, b = bh >> 3, h = bh & 7;
        if (c == 0) { if (tid < 256) SEL[(size_t)bh * SEQ_ + tid] = 0xFFFFFFu; continue; }
        bf16x8 qa[2][4];
#pragma unroll
        for (int mt = 0; mt < 2; ++mt) { const bf16_t* q = AQ + (size_t)(b * SEQ_ + c * 256 + wid * 32 + mt * 16 + fr) * 1024 + h * 128 + fq * 8;
#pragma unroll
            for (int ks = 0; ks < 4; ++ks) qa[mt][ks] = *(const bf16x8*)(q + ks * 32); }
        for (int i = tid; i < 32 * 128; i += 512) { const int n = i >> 7, d = i & 127; const float v = (n < c) ? KM[(size_t)bh * 32 * 128 + i] : 0.f;
            const unsigned hi = cvt_pk_bf16(v, 0.f) & 0xffffu; const float r = v - __builtin_bit_cast(float, hi << 16);
            kmh[n * 136 + d] = (bf16_t)hi; kml[n * 136 + d] = (bf16_t)(cvt_pk_bf16(r, 0.f) & 0xffffu); }
        __syncthreads();
#pragma unroll
        for (int nt = 0; nt < 2; ++nt) { bf16x8 bh_[4], bl_[4];
#pragma unroll
            for (int ks = 0; ks < 4; ++ks) { bh_[ks] = *(const bf16x8*)(kmh + (nt * 16 + fr) * 136 + ks * 32 + fq * 8); bl_[ks] = *(const bf16x8*)(kml + (nt * 16 + fr) * 136 + ks * 32 + fq * 8); }
#pragma unroll
            for (int mt = 0; mt < 2; ++mt) { f32x4 a4 = (f32x4){0.f, 0.f, 0.f, 0.f};
#pragma unroll
                for (int ks = 0; ks < 4; ++ks) { a4 = __builtin_amdgcn_mfma_f32_16x16x32_bf16(qa[mt][ks], bl_[ks], a4, 0, 0, 0); a4 = __builtin_amdgcn_mfma_f32_16x16x32_bf16(qa[mt][ks], bh_[ks], a4, 0, 0, 0); }
#pragma unroll
                for (int jj = 0; jj < 4; ++jj) sc[(wid * 32 + mt * 16 + fq * 4 + jj) * 33 + nt * 16 + fr] = a4[jj]; } }
        __syncthreads();
        if (tid < 256) { float b0 = -INFINITY, b1 = -INFINITY, b2 = -INFINITY; unsigned i0 = 0xFF, i1 = 0xFF, i2 = 0xFF;
            for (int n = 0; n < c; ++n) { const float s = sc[tid * 33 + n];
                if (s > b0) { b2 = b1; i2 = i1; b1 = b0; i1 = i0; b0 = s; i0 = n; }
                else if (s > b1) { b2 = b1; i2 = i1; b1 = s; i1 = n; }
                else if (s > b2) { b2 = s; i2 = n; } }
            SEL[(size_t)bh * SEQ_ + c * 256 + tid] = i0 | (i1 << 8) | (i2 << 16); }
        __syncthreads();
    }
}
struct MobaDef { u32x4 v[4]; float lse; bf16_t* op; float* lp; bool val; };
template <bool OWN, bool DEFER = false> __device__ __forceinline__ void moba_group(const bf16_t* Kl, const bf16_t* VTl, bf16x8 (&bq)[4], int g, int rcaus, bool valid, size_t ro, bf16_t* OP, float* LSE, int fr, int fq,
                                                                             MobaDef& D, const bf16_t* nq, bool has_next) {
#define MG_SCHED __builtin_amdgcn_sched_barrier(0)
    f32x4 acc[16];
    const bf16_t* kp = Kl + fr * 136 + fq * 8;
    bf16x8 ka[4][4];
#pragma unroll
    for (int pm = 0; pm < 3; ++pm)
#pragma unroll
        for (int ks = 0; ks < 4; ++ks) ka[pm][ks] = *(const bf16x8*)(kp + pm * 16 * 136 + ks * 32);
#pragma unroll
    for (int mt = 0; mt < 16; ++mt) {
        if (mt < 13) {
#pragma unroll
            for (int ks = 0; ks < 4; ++ks) ka[(mt + 3) & 3][ks] = *(const bf16x8*)(kp + (mt + 3) * 16 * 136 + ks * 32); }
        MG_SCHED;
        if (!OWN || mt <= g) { acc[mt] = (f32x4){0.f, 0.f, 0.f, 0.f};
#pragma unroll
            for (int ks = 0; ks < 4; ++ks) acc[mt] = __builtin_amdgcn_mfma_f32_16x16x32_bf16(ka[mt & 3][ks], bq[ks], acc[mt], 0, 0, 0); }
        else acc[mt] = (f32x4){-INFINITY, -INFINITY, -INFINITY, -INFINITY};
        MG_SCHED; }
    if (DEFER) {
        if (D.val) {
#pragma unroll
            for (int p = 0; p < 4; ++p) *(u32x4*)(D.op + p * 32) = D.v[p];
            if (fq == 0) *D.lp = D.lse; }
        if (has_next) {
#pragma unroll
            for (int ks = 0; ks < 4; ++ks) bq[ks] = *(const bf16x8*)(nq + ks * 32); } }
    const bf16_t* vp0 = VTl + fr * 264 + fq * 8;
    u32x4 va[4][4];
#pragma unroll
    for (int s = 0; s < 3; ++s)
#pragma unroll
        for (int d = 0; d < 4; ++d) va[s][d] = *(const u32x4*)(vp0 + ((s & 1) * 4 + d) * 16 * 264 + (s >> 1) * 32);
    float mx = -INFINITY;
#pragma unroll
    for (int mt = 0; mt < 16; ++mt)
#pragma unroll
        for (int jj = 0; jj < 4; ++jj) { float s = acc[mt][jj]; if (OWN) { const int key = mt * 16 + fq * 4 + jj; s = (key > rcaus) ? -INFINITY : s; acc[mt][jj] = s; } mx = fmaxf(mx, s); }
    mx = fmaxf(mx, __shfl_xor(mx, 16)); mx = fmaxf(mx, __shfl_xor(mx, 32));
    float l = 0.f;
#pragma unroll
    for (int mt = 0; mt < 16; ++mt)
#pragma unroll
        for (int jj = 0; jj < 4; ++jj) { const float pv = __builtin_amdgcn_exp2f(acc[mt][jj] - mx); acc[mt][jj] = pv; l += pv; }
    l += __shfl_xor(l, 16); l += __shfl_xor(l, 32);
    f32x4 o[8];
#pragma unroll
    for (int dt = 0; dt < 8; ++dt) o[dt] = (f32x4){0.f, 0.f, 0.f, 0.f};
    bf16x8 pb;
#pragma unroll
    for (int s = 0; s < 16; ++s) { const int k2 = s >> 1;
        if (s < 13) {
#pragma unroll
            for (int d = 0; d < 4; ++d) va[(s + 3) & 3][d] = *(const u32x4*)(vp0 + (((s + 3) & 1) * 4 + d) * 16 * 264 + ((s + 3) >> 1) * 32); }
        MG_SCHED;
        if (!OWN || 2 * k2 <= g) {
            if ((s & 1) == 0) { u32x4 pw; pw.x = cvt_pk_bf16(acc[2 * k2][0], acc[2 * k2][1]); pw.y = cvt_pk_bf16(acc[2 * k2][2], acc[2 * k2][3]);
                pw.z = cvt_pk_bf16(acc[2 * k2 + 1][0], acc[2 * k2 + 1][1]); pw.w = cvt_pk_bf16(acc[2 * k2 + 1][2], acc[2 * k2 + 1][3]);
                pb = __builtin_bit_cast(bf16x8, pw); }
#pragma unroll
            for (int d = 0; d < 4; ++d) o[(s & 1) * 4 + d] = __builtin_amdgcn_mfma_f32_16x16x32_bf16(__builtin_bit_cast(bf16x8, va[s & 3][d]), pb, o[(s & 1) * 4 + d], 0, 0, 0); }
        MG_SCHED; }
    {
      const float inv = __builtin_amdgcn_rcpf(l);
      u32x2 w[8];
#pragma unroll
      for (int dt = 0; dt < 8; ++dt) { w[dt].x = cvt_pk_bf16(o[dt][0] * inv, o[dt][1] * inv); w[dt].y = cvt_pk_bf16(o[dt][2] * inv, o[dt][3] * inv); }
      bf16_t* op = OP + ro * 128 + ((fq & 1) ? 16 + (fq - 1) * 4 : fq * 4);
#pragma unroll
      for (int p = 0; p < 4; ++p) { const u32x2 rx = __builtin_amdgcn_permlane16_swap(w[2 * p].x, w[2 * p + 1].x, false, false), ry = __builtin_amdgcn_permlane16_swap(w[2 * p].y, w[2 * p + 1].y, false, false);
          u32x4 v; v.x = rx[0]; v.y = ry[0]; v.z = rx[1]; v.w = ry[1];
          if (DEFER) D.v[p] = v; else if (valid) *(u32x4*)(op + p * 32) = v; }
      const float lse2 = mx + __builtin_amdgcn_logf(l);
      if (DEFER) { D.op = op; D.lp = LSE + ro; D.lse = lse2; D.val = valid; } else if (valid && fq == 0) LSE[ro] = lse2; }
#undef MG_SCHED
}
__device__ void moba_unit(const Params& P, int b, int h, int j, unsigned char* lds) {
    const int tid = threadIdx.x, lane = tid & 63, wid = tid >> 6, fr = lane & 15, fq = lane >> 4;
    bf16_t* Kl = (bf16_t*)lds;
    bf16_t* VTl = (bf16_t*)(lds + 69632);
    unsigned short* list = (unsigned short*)(lds + 139264);
    int* cnt = (int*)(lds + 139264 + 15872);
    const bf16_t* AQ = (const bf16_t*)(P.ws + WS_Z) + PL_AQ * PLANE; const bf16_t* AK = (const bf16_t*)(P.ws + WS_Z) + PL_AK * PLANE; const bf16_t* AV = (const bf16_t*)(P.ws + WS_Z) + PL_AV * PLANE;
    const unsigned* SEL = (const unsigned*)(P.ws + WS_SEL); float* LSE = (float*)(P.ws + WS_LSE); bf16_t* OP = (bf16_t*)P.out;
    const int bh = b * 8 + h; const size_t base = (size_t)b * SEQ_ + (size_t)j * 256;
    __syncthreads();
    if (tid == 0) *cnt = 0;
    { const int r = tid >> 1, hf = tid & 1; const size_t go = (base + r) * 1024 + h * 128 + hf * 64;
      const int cr = (r & ~31) | (((r >> 2) & 3) << 3) | (((r >> 4) & 1) << 2) | (r & 3);
      u32x4 kv[8], vv[8];
#pragma unroll
      for (int i = 0; i < 8; ++i) { kv[i] = *(const u32x4*)(AK + go + i * 8); vv[i] = *(const u32x4*)(AV + go + i * 8); }
#pragma unroll
      for (int i = 0; i < 8; ++i) *(u32x4*)(Kl + r * 136 + hf * 64 + i * 8) = kv[i];
#pragma unroll
      for (int i = 0; i < 8; ++i) { const int d0 = hf * 64 + i * 8;
          VTl[(d0 + 0) * 264 + cr] = (bf16_t)(vv[i].x & 0xffff); VTl[(d0 + 1) * 264 + cr] = (bf16_t)(vv[i].x >> 16);
          VTl[(d0 + 2) * 264 + cr] = (bf16_t)(vv[i].y & 0xffff); VTl[(d0 + 3) * 264 + cr] = (bf16_t)(vv[i].y >> 16);
          VTl[(d0 + 4) * 264 + cr] = (bf16_t)(vv[i].z & 0xffff); VTl[(d0 + 5) * 264 + cr] = (bf16_t)(vv[i].z >> 16);
          VTl[(d0 + 6) * 264 + cr] = (bf16_t)(vv[i].w & 0xffff); VTl[(d0 + 7) * 264 + cr] = (bf16_t)(vv[i].w >> 16); } }
    __syncthreads();
    for (int t0 = (j + 1) * 256 + tid; t0 < SEQ_; t0 += 2048) {
        unsigned sv[4];
#pragma unroll
        for (int q = 0; q < 4; ++q) { const int t = t0 + q * 512; sv[q] = (t < SEQ_) ? SEL[(size_t)bh * SEQ_ + t] : 0xFFFFFFFFu; }
#pragma unroll
        for (int q = 0; q < 4; ++q) { const unsigned s = sv[q]; const int t = t0 + q * 512;
            const int sl = ((s & 0xFF) == (unsigned)j) ? 0 : (((s >> 8) & 0xFF) == (unsigned)j) ? 1 : (((s >> 16) & 0xFF) == (unsigned)j) ? 2 : -1;
            if (sl >= 0 && t < SEQ_) { const int pos = atomicAdd(cnt, 1); list[pos] = (unsigned short)(t | (sl << 13)); } } }
    __syncthreads();
    const int nl = *cnt, NGg = (nl + 15) / 16;
    const size_t qb = (size_t)b * SEQ_;
    { bf16x8 bq[4], bn[4]; MobaDef D0; D0.val = false;
      { const bf16_t* qrow = AQ + (qb + j * 256 + wid * 16 + fr) * 1024 + h * 128;
#pragma unroll
        for (int ks = 0; ks < 4; ++ks) bq[ks] = *(const bf16x8*)(qrow + ks * 32 + fq * 8); }
      { const bf16_t* qrow = AQ + (qb + j * 256 + (wid + 8) * 16 + fr) * 1024 + h * 128;
#pragma unroll
        for (int ks = 0; ks < 4; ++ks) bn[ks] = *(const bf16x8*)(qrow + ks * 32 + fq * 8); }
      { const int rc = wid * 16 + fr; moba_group<true>(Kl, VTl, bq, wid, rc, true, ((qb + j * 256 + rc) * 8 + h) * 4 + 3, OP, LSE, fr, fq, D0, AQ, false); }
      { const int rc = (wid + 8) * 16 + fr; moba_group<true>(Kl, VTl, bn, wid + 8, rc, true, ((qb + j * 256 + rc) * 8 + h) * 4 + 3, OP, LSE, fr, fq, D0, AQ, false); } }
    if (wid < NGg) {
        bf16x8 bq[4]; int gi = wid;
        int idx = gi * 16 + fr; bool valid = idx < nl; unsigned e = list[valid ? idx : 0];
        { const bf16_t* qrow = AQ + (qb + (e & 0x1FFF)) * 1024 + h * 128;
#pragma unroll
          for (int ks = 0; ks < 4; ++ks) bq[ks] = *(const bf16x8*)(qrow + ks * 32 + fq * 8); }
        MobaDef D; D.val = false; D.op = OP; D.lp = LSE; D.lse = 0.f;
#pragma unroll
        for (int p = 0; p < 4; ++p) D.v[p] = (u32x4){0u, 0u, 0u, 0u};
        for (;;) {
            const int gn = gi + 8; const bool hn = gn < NGg;
            unsigned en = 0; bool vn = false;
            if (hn) { const int idn = gn * 16 + fr; vn = idn < nl; en = list[vn ? idn : 0]; }
            const bf16_t* nq = AQ + (qb + (en & 0x1FFF)) * 1024 + h * 128 + fq * 8;
            moba_group<false, true>(Kl, VTl, bq, 0, 0, valid, ((qb + (e & 0x1FFF)) * 8 + h) * 4 + (e >> 13), OP, LSE, fr, fq, D, nq, hn);
            if (!hn) break;
            e = en; valid = vn; gi = gn;
        }
        if (D.val) {
#pragma unroll
            for (int p = 0; p < 4; ++p) *(u32x4*)(D.op + p * 32) = D.v[p];
            if (fq == 0) *D.lp = D.lse; }
    }
}
__device__ __forceinline__ float logsig(float x) { return fminf(x, 0.f) - log1pf(expf(-fabsf(x))); }
__device__ void mlstm_prep_phase(const Params& P) {
    const int tid = threadIdx.x, lane = tid & 63, wid = tid >> 6;
    const bf16_t* QK = (const bf16_t*)(P.ws + WS_Z) + PL_QK * PLANE; bf16_t* QKC = (bf16_t*)(P.ws + WS_QKC);
    const int gtid = blockIdx.x * 512 + tid, gs = gridDim.x * 512;
    if ((gs & 127) == 0) {
        const int col = (gtid & 127) * 8;
        float cw[4][8], cb[8];
#pragma unroll
        for (int jt = 0; jt < 4; ++jt)
#pragma unroll
            for (int c = 0; c < 8; ++c) cw[jt][c] = P.conv_w[jt * 1024 + col + c];
#pragma unroll
        for (int c = 0; c < 8; ++c) cb[c] = P.conv_b[col + c];
        const float oscale = (col >= 512) ? 0.08838834764831845f : 1.0f;
        for (int task = gtid; task < (T_ / 4) * 128; task += gs) {
            const int row0 = (task >> 7) * 4, tin = row0 & (SEQ_ - 1);
            float xr[7][8];
#pragma unroll
            for (int r = 0; r < 7; ++r) { u32x4 w = (u32x4){0u, 0u, 0u, 0u};
                if (tin - 3 + r >= 0) w = *(const u32x4*)(QK + (size_t)(row0 - 3 + r) * 1024 + col);
                xr[r][0] = bf_lo(w.x); xr[r][1] = bf_hi(w.x); xr[r][2] = bf_lo(w.y); xr[r][3] = bf_hi(w.y); xr[r][4] = bf_lo(w.z); xr[r][5] = bf_hi(w.z); xr[r][6] = bf_lo(w.w); xr[r][7] = bf_hi(w.w); }
#pragma unroll
            for (int i = 0; i < 4; ++i) { float y[8];
#pragma unroll
                for (int c = 0; c < 8; ++c) { const float s = cb[c] + cw[0][c] * xr[i][c] + cw[1][c] * xr[i + 1][c] + cw[2][c] * xr[i + 2][c] + cw[3][c] * xr[i + 3][c]; y[c] = s * sigm(s) * oscale; }
                u32x4 w; w.x = cvt_pk_bf16(y[0], y[1]); w.y = cvt_pk_bf16(y[2], y[3]); w.z = cvt_pk_bf16(y[4], y[5]); w.w = cvt_pk_bf16(y[6], y[7]);
                *(u32x4*)(QKC + (size_t)(row0 + i) * 1024 + col) = w; }
        }
    }
    const float* IF = (const float*)(P.ws + WS_IF); float* GB = (float*)(P.ws + WS_GB); float* GU = (float*)(P.ws + WS_GU); float* GCM = (float*)(P.ws + WS_GCM);
    for (int wt = blockIdx.x * 8 + wid; wt < 16 * 128; wt += gridDim.x * 8) { const int bh = wt >> 7, n = wt & 127, b = bh >> 2, h = bh & 3;
        const size_t row = (size_t)b * SEQ_ + n * 64 + lane;
        const float ig = IF[row * 8 + h], fp = IF[row * 8 + 4 + h];
        float bs = logsig(fp);
#pragma unroll
        for (int d = 1; d < 64; d <<= 1) { const float t = __shfl_up(bs, d); if (lane >= d) bs += t; }
        const float u = ig - bs; float cm = u;
#pragma unroll
        for (int d = 1; d < 64; d <<= 1) { const float t = __shfl_up(cm, d); if (lane >= d) cm = fmaxf(cm, t); }
        const size_t o = (size_t)bh * SEQ_ + n * 64 + lane; GB[o] = bs; GU[o] = u; GCM[o] = cm; }
}
template <bool FULL> __device__ void mlstm_seg(const Params& P, int unit, unsigned char* lds) {
    const int tid = opaque_tid(), lane = tid & 63, wid = tid >> 6, fr = lane & 15, fq = lane >> 4;
    const int bh = unit >> 4, seg = unit & 15, b = bh >> 2, h = bh & 3;
    bf16_t* Qs = (bf16_t*)lds;
    bf16_t* Ks = Qs + 64 * 136;
    bf16_t* KsT = Ks + 64 * 136;
    bf16_t* KWT = KsT + 128 * 72;
    bf16_t* VT = KWT + 128 * 72;
    bf16_t* Ps = VT + 256 * 72;
    float* FL = (float*)(Ps + 64 * 72);
    float* NV = FL + 512;
    const bf16_t* QKC = (const bf16_t*)(P.ws + WS_QKC); const bf16_t* MV = (const bf16_t*)(P.ws + WS_Z) + PL_MV * PLANE;
    const float* GB = (const float*)(P.ws + WS_GB) + (size_t)bh * SEQ_; const float* GU = (const float*)(P.ws + WS_GU) + (size_t)bh * SEQ_; const float* GCM = (const float*)(P.ws + WS_GCM) + (size_t)bh * SEQ_;
    bf16_t* HU = (bf16_t*)(P.ws + WS_HU); float* LG = (float*)(P.ws + WS_LG); const float* CI = (const float*)(P.ws + WS_CI); float* LDp = (float*)(P.ws + WS_LD);
    __syncthreads();
    const int n0 = seg * 8;
    float m_prev = 0.f, dprod = 1.f;
    if (wid == 0) {
#pragma unroll
        for (int rnd = 0; rnd < 2; ++rnd) { const int n = rnd * 64 + lane; float a = 0.f, bb = -INFINITY;
            if (n < n0) { const float g = GB[n * 64 + 63], c = GCM[n * 64 + 63]; a = g; bb = c + g; }
#pragma unroll
            for (int d = 1; d < 64; d <<= 1) { const float ta = __shfl_up(a, d), tb = __shfl_up(bb, d); if (lane >= d) { bb = fmaxf(tb + a, bb); a = ta + a; } }
            const float A = __shfl(a, 63), B = __shfl(bb, 63); m_prev = fmaxf(m_prev + A, B); }
    }
    const int cs0 = wid, cs1 = wid + 8;
    f32x4 Cacc[8][2];
#pragma unroll
    for (int dt = 0; dt < 8; ++dt)
#pragma unroll
        for (int s = 0; s < 2; ++s) { Cacc[dt][s] = (f32x4){0.f, 0.f, 0.f, 0.f};
            if (FULL) { const int c = (s == 0 ? cs0 : cs1) * 16 + fr;
                Cacc[dt][s] = *(const f32x4*)(CI + ((size_t)unit * 272 + c) * 128 + dt * 16 + fq * 4); } }
    float nreg = 0.f;
    if (tid < 128) { if (FULL) nreg = CI[((size_t)unit * 272 + 256) * 128 + tid]; NV[tid] = nreg; }
    const int cgI = tid & 31, rg = tid >> 5, isK = cgI >> 4, chl = (cgI & 15) * 8, col = isK * 512 + h * 128 + chl, l0 = rg * 4;
    const int vg = tid & 31, tg = tid >> 5;
    const size_t seqb = (size_t)b * SEQ_;
#pragma unroll 1
    for (int k = 0; k < 8; ++k) {
        const int n = n0 + k; const size_t rowb = seqb + (size_t)n * 64;
        if (FULL || isK) { u32x4 rq[4];
#pragma unroll
            for (int i = 0; i < 4; ++i) rq[i] = *(const u32x4*)(QKC + (rowb + l0 + i) * 1024 + col);
            bf16_t* dst = isK ? Ks : Qs;
#pragma unroll
            for (int i = 0; i < 4; ++i) *(u32x4*)(dst + (l0 + i) * 136 + chl) = rq[i];
            if (isK) { const unsigned q0[4] = {rq[0].x, rq[0].y, rq[0].z, rq[0].w}, q1[4] = {rq[1].x, rq[1].y, rq[1].z, rq[1].w}, q2[4] = {rq[2].x, rq[2].y, rq[2].z, rq[2].w}, q3[4] = {rq[3].x, rq[3].y, rq[3].z, rq[3].w};
#pragma unroll
                for (int c2 = 0; c2 < 4; ++c2) { u32x2 wl, wh;
                    wl.x = (q0[c2] & 0xffffu) | (q1[c2] << 16); wl.y = (q2[c2] & 0xffffu) | (q3[c2] << 16);
                    wh.x = (q0[c2] >> 16) | (q1[c2] & 0xffff0000u); wh.y = (q2[c2] >> 16) | (q3[c2] & 0xffff0000u);
                    *(u32x2*)(KsT + (chl + 2 * c2) * 72 + l0) = wl; *(u32x2*)(KsT + (chl + 2 * c2 + 1) * 72 + l0) = wh; } } }
        { u32x4 rv[4];
#pragma unroll
          for (int i = 0; i < 4; ++i) rv[i] = *(const u32x4*)(MV + (rowb + tg * 4 + i) * 1024 + h * 256 + vg * 8);
          const unsigned q0[4] = {rv[0].x, rv[0].y, rv[0].z, rv[0].w}, q1[4] = {rv[1].x, rv[1].y, rv[1].z, rv[1].w}, q2[4] = {rv[2].x, rv[2].y, rv[2].z, rv[2].w}, q3[4] = {rv[3].x, rv[3].y, rv[3].z, rv[3].w};
#pragma unroll
          for (int c2 = 0; c2 < 4; ++c2) { u32x2 wl, wh;
              wl.x = (q0[c2] & 0xffffu) | (q1[c2] << 16); wl.y = (q2[c2] & 0xffffu) | (q3[c2] << 16);
              wh.x = (q0[c2] >> 16) | (q1[c2] & 0xffff0000u); wh.y = (q2[c2] >> 16) | (q3[c2] & 0xffff0000u);
              *(u32x2*)(VT + (vg * 8 + 2 * c2) * 72 + tg * 4) = wl; *(u32x2*)(VT + (vg * 8 + 2 * c2 + 1) * 72 + tg * 4) = wh; } }
        if (wid == 0) { const float gb = GB[n * 64 + lane], gu = GU[n * 64 + lane], gcm = GCM[n * 64 + lane];
            const float Mx = fmaxf(m_prev, gcm), ei = __expf(m_prev - Mx); const float Mtot = __shfl(Mx, 63), g_ = __shfl(gb, 63);
            FL[lane] = gu; FL[64 + lane] = Mx; FL[128 + lane] = ei; FL[192 + lane] = __expf(gu - Mtot); FL[256 + lane] = __expf(-(gb + Mx));
            const float dec = __expf(m_prev - Mtot); if (lane == 0) FL[384] = dec; dprod *= dec; m_prev = g_ + Mtot; }
        LBAR();
        { const int idx = tid * 16, d = idx >> 6, s0 = idx & 63; const u32x4 a = *(const u32x4*)(KsT + d * 72 + s0), c = *(const u32x4*)(KsT + d * 72 + s0 + 8);
          const float4 w0 = *(const float4*)(FL + 192 + s0), w1 = *(const float4*)(FL + 192 + s0 + 4), w2 = *(const float4*)(FL + 192 + s0 + 8), w3 = *(const float4*)(FL + 192 + s0 + 12);
          u32x4 oa, oc; oa.x = cvt_pk_bf16(bf_lo(a.x) * w0.x, bf_hi(a.x) * w0.y); oa.y = cvt_pk_bf16(bf_lo(a.y) * w0.z, bf_hi(a.y) * w0.w); oa.z = cvt_pk_bf16(bf_lo(a.z) * w1.x, bf_hi(a.z) * w1.y); oa.w = cvt_pk_bf16(bf_lo(a.w) * w1.z, bf_hi(a.w) * w1.w);
          oc.x = cvt_pk_bf16(bf_lo(c.x) * w2.x, bf_hi(c.x) * w2.y); oc.y = cvt_pk_bf16(bf_lo(c.y) * w2.z, bf_hi(c.y) * w2.w); oc.z = cvt_pk_bf16(bf_lo(c.z) * w3.x, bf_hi(c.z) * w3.y); oc.w = cvt_pk_bf16(bf_lo(c.w) * w3.z, bf_hi(c.w) * w3.w);
          *(u32x4*)(KWT + d * 72 + s0) = oa; *(u32x4*)(KWT + d * 72 + s0 + 8) = oc; }
        if (FULL) {
#pragma unroll
            for (int x = 0; x < 2; ++x) { const int tile = 2 * wid + x, ti = tile >> 2, si = tile & 3;
                f32x4 a4 = (f32x4){0.f, 0.f, 0.f, 0.f};
                if (si <= ti) {
#pragma unroll
                    for (int ks = 0; ks < 4; ++ks) { const bf16x8 a = *(const bf16x8*)(Qs + (ti * 16 + fr) * 136 + ks * 32 + fq * 8); const bf16x8 bb2 = *(const bf16x8*)(Ks + (si * 16 + fr) * 136 + ks * 32 + fq * 8);
                        a4 = __builtin_amdgcn_mfma_f32_16x16x32_bf16(a, bb2, a4, 0, 0, 0); } }
                const int s = si * 16 + fr; const float us = FL[s]; const float4 mx4 = *(const float4*)(FL + 64 + ti * 16 + fq * 4); const float mxa[4] = {mx4.x, mx4.y, mx4.z, mx4.w};
#pragma unroll
                for (int jj = 0; jj < 4; ++jj) { const int t = ti * 16 + fq * 4 + jj; const float e = __expf(us - mxa[jj]); const float pv = (s <= t) ? a4[jj] * e : 0.f;
                    Ps[t * 72 + s] = (bf16_t)(cvt_pk_bf16(pv, 0.f) & 0xffff); } } }
        LBAR();
        const float decay = FL[384];
        u32x4 Cb[2][4];
        if (FULL) {
#pragma unroll
            for (int s = 0; s < 2; ++s)
#pragma unroll
                for (int q = 0; q < 4; ++q) { Cb[s][q].x = cvt_pk_bf16(Cacc[2 * q][s][0], Cacc[2 * q][s][1]); Cb[s][q].y = cvt_pk_bf16(Cacc[2 * q][s][2], Cacc[2 * q][s][3]);
                    Cb[s][q].z = cvt_pk_bf16(Cacc[2 * q + 1][s][0], Cacc[2 * q + 1][s][1]); Cb[s][q].w = cvt_pk_bf16(Cacc[2 * q + 1][s][2], Cacc[2 * q + 1][s][3]); } }
        bf16x8 VTb[2][2];
#pragma unroll
        for (int ks = 0; ks < 2; ++ks) { VTb[0][ks] = *(const bf16x8*)(VT + (cs0 * 16 + fr) * 72 + ks * 32 + fq * 8); VTb[1][ks] = *(const bf16x8*)(VT + (cs1 * 16 + fr) * 72 + ks * 32 + fq * 8); }
        { const float* nv_old = NV + (k & 1) * 128; float* nv_new = NV + ((k + 1) & 1) * 128;
          if (FULL) {
              const int t_ = tid >> 3, part = tid & 7;
              const u32x4 qa = *(const u32x4*)(Qs + t_ * 136 + part * 16), qb = *(const u32x4*)(Qs + t_ * 136 + part * 16 + 8);
              const float4 n0v = *(const float4*)(nv_old + part * 16), n1v = *(const float4*)(nv_old + part * 16 + 4), n2v = *(const float4*)(nv_old + part * 16 + 8), n3v = *(const float4*)(nv_old + part * 16 + 12);
              float qn = bf_lo(qa.x) * n0v.x + bf_hi(qa.x) * n0v.y + bf_lo(qa.y) * n0v.z + bf_hi(qa.y) * n0v.w + bf_lo(qa.z) * n1v.x + bf_hi(qa.z) * n1v.y + bf_lo(qa.w) * n1v.z + bf_hi(qa.w) * n1v.w
                       + bf_lo(qb.x) * n2v.x + bf_hi(qb.x) * n2v.y + bf_lo(qb.y) * n2v.z + bf_hi(qb.y) * n2v.w + bf_lo(qb.z) * n3v.x + bf_hi(qb.z) * n3v.y + bf_lo(qb.w) * n3v.z + bf_hi(qb.w) * n3v.w;
              const u32x4 pr = *(const u32x4*)(Ps + t_ * 72 + part * 8);
              const float rs = bf_lo(pr.x) + bf_hi(pr.x) + bf_lo(pr.y) + bf_hi(pr.y) + bf_lo(pr.z) + bf_hi(pr.z) + bf_lo(pr.w) + bf_hi(pr.w);
              float v = FL[128 + t_] * qn + rs;
              v += __shfl_xor(v, 1); v += __shfl_xor(v, 2); v += __shfl_xor(v, 4);
              if (part == 0) FL[320 + t_] = v; }
          if (tid < 128) {
              float acc = 0.f;
#pragma unroll
              for (int i = 0; i < 8; ++i) { const u32x4 kw = *(const u32x4*)(KWT + tid * 72 + i * 8);
                  acc += bf_lo(kw.x) + bf_hi(kw.x) + bf_lo(kw.y) + bf_hi(kw.y) + bf_lo(kw.z) + bf_hi(kw.z) + bf_lo(kw.w) + bf_hi(kw.w); }
              nreg = nreg * decay + acc; nv_new[tid] = nreg; } }
#pragma unroll
        for (int dt = 0; dt < 8; ++dt) { const bf16x8 a0 = *(const bf16x8*)(KWT + (dt * 16 + fr) * 72 + fq * 8), a1 = *(const bf16x8*)(KWT + (dt * 16 + fr) * 72 + 32 + fq * 8);
#pragma unroll
            for (int s = 0; s < 2; ++s) {
                f32x4 c = Cacc[dt][s] * decay; c = __builtin_amdgcn_mfma_f32_16x16x32_bf16(a0, VTb[s][0], c, 0, 0, 0); c = __builtin_amdgcn_mfma_f32_16x16x32_bf16(a1, VTb[s][1], c, 0, 0, 0); Cacc[dt][s] = c; } }
        LBAR();
        if (FULL) {
#pragma unroll 1
            for (int ti = 0; ti < 4; ++ti) {
                u32x4 aq[4];
#pragma unroll
                for (int q = 0; q < 4; ++q) { const bf16_t* qp = Qs + (ti * 16 + fr) * 136 + q * 32 + fq * 4; const u32x2 a0 = *(const u32x2*)qp, a1 = *(const u32x2*)(qp + 16); aq[q].x = a0.x; aq[q].y = a0.y; aq[q].z = a1.x; aq[q].w = a1.y; }
                const bf16x8 ap0 = *(const bf16x8*)(Ps + (ti * 16 + fr) * 72 + fq * 8), ap1 = *(const bf16x8*)(Ps + (ti * 16 + fr) * 72 + 32 + fq * 8);
                const float4 e4 = *(const float4*)(FL + 128 + ti * 16 + fq * 4), d4 = *(const float4*)(FL + 320 + ti * 16 + fq * 4), b4 = *(const float4*)(FL + 256 + ti * 16 + fq * 4);
                const float rd[4] = {__builtin_amdgcn_rcpf(fmaxf(fabsf(d4.x), b4.x)), __builtin_amdgcn_rcpf(fmaxf(fabsf(d4.y), b4.y)), __builtin_amdgcn_rcpf(fmaxf(fabsf(d4.z), b4.z)), __builtin_amdgcn_rcpf(fmaxf(fabsf(d4.w), b4.w))};
#pragma unroll
                for (int s = 0; s < 2; ++s) { f32x4 nacc = (f32x4){0.f, 0.f, 0.f, 0.f};
#pragma unroll
                    for (int q = 0; q < 4; ++q) nacc = __builtin_amdgcn_mfma_f32_16x16x32_bf16(__builtin_bit_cast(bf16x8, aq[q]), __builtin_bit_cast(bf16x8, Cb[s][q]), nacc, 0, 0, 0);
                    nacc[0] *= e4.x; nacc[1] *= e4.y; nacc[2] *= e4.z; nacc[3] *= e4.w;
                    nacc = __builtin_amdgcn_mfma_f32_16x16x32_bf16(ap0, VTb[s][0], nacc, 0, 0, 0); nacc = __builtin_amdgcn_mfma_f32_16x16x32_bf16(ap1, VTb[s][1], nacc, 0, 0, 0);
                    bf16_t* hp = HU + (rowb + ti * 16 + fq * 4) * 1024 + h * 256 + (s == 0 ? cs0 : cs1) * 16 + fr;
#pragma unroll
                    for (int jj = 0; jj < 4; ++jj) hp[jj * 1024] = (bf16_t)(cvt_pk_bf16(nacc[jj] * rd[jj], 0.f) & 0xffff); } }
            LBAR();
        }
    }
    if (!FULL) {
#pragma unroll
        for (int dt = 0; dt < 8; ++dt)
#pragma unroll
            for (int s = 0; s < 2; ++s) { const int c = (s == 0 ? cs0 : cs1) * 16 + fr;
                *(f32x4*)(LG + ((size_t)unit * 272 + c) * 128 + dt * 16 + fq * 4) = Cacc[dt][s]; }
        if (tid < 128) LG[((size_t)unit * 272 + 256) * 128 + tid] = nreg;
        if (tid == 0) LDp[unit] = dprod;
    }
}
__device__ void mlstm_pass2(const Params& P) {
    const float* LG = (const float*)(P.ws + WS_LG); float* CI = (float*)(P.ws + WS_CI); const float* LDp = (const float*)(P.ws + WS_LD);
    const int gtid = blockIdx.x * 512 + opaque_tid(), gs = gridDim.x * 512;
    for (int task = gtid; task < 16 * 257 * 32; task += gs) { const int d4 = task & 31, c = (task >> 5) % 257, bh = task / (257 * 32);
        f32x4 L[16]; float D[16];
#pragma unroll
        for (int g = 0; g < 16; ++g) { L[g] = *(const f32x4*)(LG + ((size_t)(bh * 16 + g) * 272 + c) * 128 + d4 * 4); D[g] = LDp[bh * 16 + g]; }
        f32x4 C = (f32x4){0.f, 0.f, 0.f, 0.f};
#pragma unroll
        for (int g = 0; g < 16; ++g) { *(f32x4*)(CI + ((size_t)(bh * 16 + g) * 272 + c) * 128 + d4 * 4) = C; C = C * D[g] + L[g]; }
    }
}
__device__ void finalize_phase(const Params& P) {
    const int tid = threadIdx.x, lane = tid & 63, wid = tid >> 6;
    const bf16_t* HU = (const bf16_t*)(P.ws + WS_HU); const bf16_t* MO = (const bf16_t*)(P.ws + WS_Z) + PL_MO * PLANE; bf16_t* HM = (bf16_t*)(P.ws + WS_HM);
    const float* LSE = (const float*)(P.ws + WS_LSE); const bf16_t* OP = (const bf16_t*)P.out; bf16_t* HA = (bf16_t*)(P.ws + WS_HA);
    float gn[16];
#pragma unroll
    for (int e = 0; e < 16; ++e) gn[e] = P.m_out_norm[lane * 16 + e];
    const int hd = lane >> 3, d0 = (lane & 7) * 16; const int rstep = gridDim.x * 8;
    float4 nls; u32x4 npa[4], npq[4], nha, nhb, nma, nmb;
#define FIN_LOAD(r_) do { const size_t ro_ = ((size_t)(r_) * 8 + hd) * 4; nls = *(const float4*)(LSE + ro_); \
        _Pragma("unroll") for (int s = 0; s < 4; ++s) { const bf16_t* op_ = OP + (ro_ + s) * 128 + d0; npa[s] = *(const u32x4*)op_; npq[s] = *(const u32x4*)(op_ + 8); } \
        const size_t off_ = (size_t)(r_) * 1024 + lane * 16; nha = *(const u32x4*)(HU + off_); nhb = *(const u32x4*)(HU + off_ + 8); nma = *(const u32x4*)(MO + off_); nmb = *(const u32x4*)(MO + off_ + 8); } while (0)
    { const int r0_ = blockIdx.x * 8 + wid; if (r0_ < T_) FIN_LOAD(r0_); }
    for (int row = blockIdx.x * 8 + wid; row < T_; row += rstep) {
        const size_t ro = ((size_t)row * 8 + hd) * 4;
        const float4 ls = nls;
        u32x4 pa[4], pq[4];
#pragma unroll
        for (int s = 0; s < 4; ++s) { pa[s] = npa[s]; pq[s] = npq[s]; }
        const u32x4 a = nha, bq = nhb, ma = nma, mb = nmb;
        if (row + rstep < T_) FIN_LOAD(row + rstep);
        { const size_t off = (size_t)row * 1024 + lane * 16;
          float v[16] = {bf_lo(a.x), bf_hi(a.x), bf_lo(a.y), bf_hi(a.y), bf_lo(a.z), bf_hi(a.z), bf_lo(a.w), bf_hi(a.w), bf_lo(bq.x), bf_hi(bq.x), bf_lo(bq.y), bf_hi(bq.y), bf_lo(bq.z), bf_hi(bq.z), bf_lo(bq.w), bf_hi(bq.w)};
          const float mo[16] = {bf_lo(ma.x), bf_hi(ma.x), bf_lo(ma.y), bf_hi(ma.y), bf_lo(ma.z), bf_hi(ma.z), bf_lo(ma.w), bf_hi(ma.w), bf_lo(mb.x), bf_hi(mb.x), bf_lo(mb.y), bf_hi(mb.y), bf_lo(mb.z), bf_hi(mb.z), bf_lo(mb.w), bf_hi(mb.w)};
          float ss = 0.f;
#pragma unroll
          for (int e = 0; e < 16; ++e) ss += v[e] * v[e];
          ss += __shfl_xor(ss, 1); ss += __shfl_xor(ss, 2); ss += __shfl_xor(ss, 4); ss += __shfl_xor(ss, 8);
          const float rinv = rsqrtf(ss * (1.0f / 256.0f) + EPS_);
#pragma unroll
          for (int e = 0; e < 16; ++e) v[e] = v[e] * rinv * gn[e] * sigm(mo[e]);
          u32x4 o0, o1; o0.x = cvt_pk_bf16(v[0], v[1]); o0.y = cvt_pk_bf16(v[2], v[3]); o0.z = cvt_pk_bf16(v[4], v[5]); o0.w = cvt_pk_bf16(v[6], v[7]);
          o1.x = cvt_pk_bf16(v[8], v[9]); o1.y = cvt_pk_bf16(v[10], v[11]); o1.z = cvt_pk_bf16(v[12], v[13]); o1.w = cvt_pk_bf16(v[14], v[15]);
          *(u32x4*)(HM + off) = o0; *(u32x4*)(HM + off + 8) = o1; }
        { const int cblk = (row & (SEQ_ - 1)) >> 8; const int nv = cblk < 3 ? cblk : 3;
          const float l0 = nv > 0 ? ls.x : -INFINITY, l1 = nv > 1 ? ls.y : -INFINITY, l2 = nv > 2 ? ls.z : -INFINITY, l3 = ls.w;
          const float M = fmaxf(fmaxf(l0, l1), fmaxf(l2, l3));
          float w[4] = {nv > 0 ? __builtin_amdgcn_exp2f(l0 - M) : 0.f, nv > 1 ? __builtin_amdgcn_exp2f(l1 - M) : 0.f, nv > 2 ? __builtin_amdgcn_exp2f(l2 - M) : 0.f, __builtin_amdgcn_exp2f(l3 - M)};
          const float inv = 1.0f / (w[0] + w[1] + w[2] + w[3]);
          float acc[16];
#pragma unroll
          for (int e = 0; e < 16; ++e) acc[e] = 0.f;
#pragma unroll
          for (int s = 0; s < 4; ++s) { if (s < 3 && s >= nv) continue; const u32x4 a = pa[s], bq = pq[s]; const float ws_ = w[s] * inv;
              acc[0] += ws_ * bf_lo(a.x); acc[1] += ws_ * bf_hi(a.x); acc[2] += ws_ * bf_lo(a.y); acc[3] += ws_ * bf_hi(a.y); acc[4] += ws_ * bf_lo(a.z); acc[5] += ws_ * bf_hi(a.z); acc[6] += ws_ * bf_lo(a.w); acc[7] += ws_ * bf_hi(a.w);
              acc[8] += ws_ * bf_lo(bq.x); acc[9] += ws_ * bf_hi(bq.x); acc[10] += ws_ * bf_lo(bq.y); acc[11] += ws_ * bf_hi(bq.y); acc[12] += ws_ * bf_lo(bq.z); acc[13] += ws_ * bf_hi(bq.z); acc[14] += ws_ * bf_lo(bq.w); acc[15] += ws_ * bf_hi(bq.w); }
          u32x4 o0, o1; o0.x = cvt_pk_bf16(acc[0], acc[1]); o0.y = cvt_pk_bf16(acc[2], acc[3]); o0.z = cvt_pk_bf16(acc[4], acc[5]); o0.w = cvt_pk_bf16(acc[6], acc[7]);
          o1.x = cvt_pk_bf16(acc[8], acc[9]); o1.y = cvt_pk_bf16(acc[10], acc[11]); o1.z = cvt_pk_bf16(acc[12], acc[13]); o1.w = cvt_pk_bf16(acc[14], acc[15]);
          bf16_t* hp = HA + (size_t)row * 1024 + hd * 128 + d0; *(u32x4*)hp = o0; *(u32x4*)(hp + 8) = o1; }
    }
#undef FIN_LOAD
}

template <class Epi> __device__ __forceinline__ void run_gemm(unsigned char* lds, const bf16_t* A, const bf16_t* Bt, int N, int K, const Epi& E) {
    pg8::Gemm g; g.A = A; g.Bt = Bt; g.M = T_; g.N = N; g.K = K;
    pg8::StaticOrder S; S.init(T_, N, (int)gridDim.x, (int)blockIdx.x);
    pg8::gemm_phase<Epi, pg8::StaticOrder, true, true>((PG8_LAS unsigned char*)lds, g, S, E);
    __syncthreads();
}

#define LAS __attribute__((address_space(3)))
#define XB_TMO      128
#define XB_XCNT(j)  (256  + 64 * (j))
#define XB_XSUB(j)  (1280 + 64 * (j))
#define XB_XGEN(j)  (2304 + 64 * (j))
#define XB_TOP      3328
#define XB_TOPGEN   3392
#define XCD_BAR_WORDS 3456
#define XB_SPIN_CAP (1u << 18)

__device__ __forceinline__ unsigned xb_ld(unsigned* p)              { return __hip_atomic_load(p, __ATOMIC_RELAXED, __HIP_MEMORY_SCOPE_AGENT); }
__device__ __forceinline__ unsigned xb_add(unsigned* p, unsigned v) { return __hip_atomic_fetch_add(p, v, __ATOMIC_RELAXED, __HIP_MEMORY_SCOPE_AGENT); }
__device__ __forceinline__ unsigned xb_xcc_id() { return (unsigned)__builtin_amdgcn_s_getreg((3 << 11) | 20) & 0xFu; }
#define XB_SPIN(cond, bar) do { unsigned _sp = 0; while (cond) { __builtin_amdgcn_s_sleep(1); \
    if ((++_sp & 255u) == 0u) { if (xb_ld(&(bar)[XB_TMO])) break; if (_sp > XB_SPIN_CAP) { atomicAdd(&(bar)[XB_TMO], 1u); break; } } } } while (0)

struct XcdBarrier {
    unsigned* bar; unsigned x;
    volatile LAS unsigned* st;
};

__device__ __forceinline__ XcdBarrier xcd_barrier_post(unsigned* bar, volatile LAS unsigned* st) {
    XcdBarrier b; b.bar = bar; b.x = xb_xcc_id(); b.st = st;
    if (threadIdx.x == 0) (void)xb_add(&bar[XB_XCNT(b.x)], 1u);
    return b;
}
__device__ __forceinline__ void xcd_barrier_complete(unsigned* bar, unsigned x, unsigned& nloc, unsigned& nx) {
    const unsigned G = gridDim.x * gridDim.y * gridDim.z;
    unsigned sum, cnt, mine, sp = 0u;
    for (;;) {
        sum = 0u; cnt = 0u; mine = 0u;
#pragma unroll
        for (unsigned j = 0; j < 16; ++j) { const unsigned c = xb_ld(&bar[XB_XCNT(j)]); sum += c; cnt += (c > 0u) ? 1u : 0u; mine = (j == x) ? c : mine; }
        if (sum == G) break;
        __builtin_amdgcn_s_sleep(1);
        if ((++sp & 255u) == 0u) { if (xb_ld(&bar[XB_TMO])) break; if (sp > XB_SPIN_CAP) { atomicAdd(&bar[XB_TMO], 1u); break; } }
    }
    nloc = mine > 0u ? mine : 1u; nx = cnt > 0u ? cnt : 1u;
}

__device__ __forceinline__ void xcd_barrier(const XcdBarrier& b) {
    asm volatile("s_waitcnt vmcnt(0)" ::: "memory");
    __syncthreads();
    if (threadIdx.x == 0) {
        unsigned* bar = b.bar;
        __builtin_amdgcn_s_waitcnt(0);
        unsigned nloc = b.st[0], nx = b.st[1];
        if (nloc == 0u) { xcd_barrier_complete(bar, b.x, nloc, nx); b.st[0] = nloc; b.st[1] = nx; }
        const unsigned old = xb_add(&bar[XB_XSUB(b.x)], 1u);
        const unsigned gen = old / nloc;
        if (old + 1u == (gen + 1u) * nloc) {
            __builtin_amdgcn_fence(__ATOMIC_RELEASE, "agent");
            asm volatile("s_waitcnt vmcnt(0)" ::: "memory");
            const unsigned og = xb_add(&bar[XB_TOP], 1u);
            const unsigned tg = og / nx;
            if (og + 1u == (tg + 1u) * nx) xb_add(&bar[XB_TOPGEN], 1u);
            else XB_SPIN(xb_ld(&bar[XB_TOPGEN]) == tg, bar);
            __builtin_amdgcn_fence(__ATOMIC_ACQUIRE, "agent");
            xb_add(&bar[XB_XGEN(b.x)], 1u);
            asm volatile("s_waitcnt vmcnt(0)" ::: "memory");
        } else {
            XB_SPIN(xb_ld(&bar[XB_XGEN(b.x)]) == gen, bar);
            __builtin_amdgcn_fence(__ATOMIC_ACQUIRE, "agent");
            asm volatile("s_waitcnt vmcnt(0)" ::: "memory");
        }
    }
    __syncthreads();
}


#define WG_LOCAL_HANDOFF() do { if (threadIdx.x == 0) { __builtin_amdgcn_fence(__ATOMIC_ACQUIRE, "agent"); asm volatile("s_waitcnt vmcnt(0)" ::: "memory"); } __syncthreads(); } while (0)
__global__ void __launch_bounds__(512, 2) mega_fwd(Params P) {
    extern __shared__ __attribute__((aligned(16))) unsigned char lds[];
    cg::grid_group grid = cg::this_grid();
    unsigned char* ws = P.ws;
    bf16_t* Z = (bf16_t*)(ws + WS_Z);
    volatile LAS unsigned* xst = (volatile LAS unsigned*)((LAS unsigned char*)lds + (LDS_BYTES - 64));
    if (threadIdx.x < 4) xst[threadIdx.x] = 0u;
    __syncthreads();
    const XcdBarrier xbar = xcd_barrier_post((unsigned*)(ws + WS_XBAR), xst);
    weights_phase(P, lds);
    rms_phase<0>(P.x, P.attn_norm, (bf16_t*)(ws + WS_XN), nullptr, P, lds);
    misc_prologue(P);
    xcd_barrier(xbar);
    if (gridDim.x == 0x7fffffffu) grid.sync();
    { pg8::EpiB<pg8::EM_Z> E{}; E.O = Z; E.ldc = 1024; E.aux1 = nullptr; E.aux2 = nullptr; E.plane = PLANE;
      run_gemm(lds, (const bf16_t*)(ws + WS_XN), (const bf16_t*)(ws + WS_WIN), NZ, 2048, E); }
    xcd_barrier(xbar);
    moba_prep_phase(P, lds);
    mlstm_prep_phase(P);
    xcd_barrier(xbar);
    for (int u = blockIdx.x; u < 256; u += gridDim.x) mlstm_seg<false>(P, u, lds);
    moba_route_phase(P, lds);
    xcd_barrier(xbar);
    mlstm_pass2(P);
    xcd_barrier(xbar);
    for (int u = blockIdx.x; u < 256; u += gridDim.x) mlstm_seg<true>(P, u, lds);
    { const int G = gridDim.x;
      const int grp = (int)blockIdx.x >> 5;
      const unsigned pk = grp == 0 ? (0u | (21u << 5) | (28u << 10) | (29u << 15)) : grp == 1 ? (1u | (18u << 5) | (22u << 10) | (31u << 15)) : grp == 2 ? (2u | (14u << 5) | (24u << 10) | (25u << 15))
                        : grp == 3 ? (3u | (12u << 5) | (17u << 10) | (30u << 15)) : grp == 4 ? (4u | (11u << 5) | (16u << 10) | (26u << 15)) : grp == 5 ? (5u | (10u << 5) | (19u << 10) | (20u << 15))
                        : grp == 6 ? (6u | (9u << 5) | (13u << 10) | (27u << 15)) : (7u | (8u << 5) | (15u << 10) | (23u << 15));
      for (int it = 0; it * G < 1024; ++it) { int j, bh;
          if (G == 256) { j = (int)((pk >> (5 * it)) & 31u); bh = (int)blockIdx.x & 31; }
          else { const int pos = (it & 1) ? (G - 1 - (int)blockIdx.x) : (int)blockIdx.x; const int u = it * G + pos; if (u >= 1024) continue; j = u >> 5; bh = u & 31; }
          moba_unit(P, bh >> 3, bh & 7, j, lds); } }
    xcd_barrier(xbar);
    finalize_phase(P);
    xcd_barrier(xbar);
    { pg8::EpiB<pg8::EM_TMP> E{}; E.O = (bf16_t*)(ws + WS_TMP); E.ldc = 2048; E.aux1 = Z + PL_GM * PLANE; E.aux2 = nullptr; E.plane = PLANE;
      run_gemm(lds, (const bf16_t*)(ws + WS_HM), (const bf16_t*)(ws + WS_WM), 2048, 1024, E); }
    WG_LOCAL_HANDOFF();
    { pg8::EpiB<pg8::EM_MG> E{}; E.O = (bf16_t*)(ws + WS_MG); E.ldc = 2048; E.aux1 = Z + PL_GA * PLANE; E.aux2 = (const bf16_t*)(ws + WS_TMP); E.plane = PLANE;
      run_gemm(lds, (const bf16_t*)(ws + WS_HA), (const bf16_t*)(ws + WS_WA), 2048, 1024, E); }
    xcd_barrier(xbar);
    { pg8::EpiF<pg8::EF_RES, true, false, true> E{}; E.Ob = (bf16_t*)(ws + WS_X1B); E.res = P.x; E.pp = nullptr; E.ldc = 2048; E.hb = (bf16_t*)(ws + WS_XN); E.gvec = P.mlp_norm; E.rsq = (float*)(ws + WS_RSQ1);
      run_gemm(lds, (const bf16_t*)(ws + WS_MG), (const bf16_t*)(ws + WS_WOUT), 2048, 2048, E); }
    xcd_barrier(xbar);
    { pg8::EpiB<pg8::EM_RELU2> E{}; E.O = (bf16_t*)(ws + WS_U); E.ldc = 8192; E.aux1 = nullptr; E.aux2 = nullptr; E.plane = 0;
      E.rsq_in = (const float*)(ws + WS_RSQ1);
      run_gemm(lds, (const bf16_t*)(ws + WS_XN), (const bf16_t*)(ws + WS_W1), 8192, 2048, E); }
    xcd_barrier(xbar);
    { pg8::EpiF<pg8::EF_RES, true, true, false> E{}; E.O = P.out; E.resb = (const bf16_t*)(ws + WS_X1B); E.pp = nullptr; E.ldc = 2048; E.hb = (bf16_t*)(ws + WS_XN); E.gvec = P.ple_norm; E.rsq = (float*)(ws + WS_RSQ2);
      run_gemm(lds, (const bf16_t*)(ws + WS_U), (const bf16_t*)(ws + WS_W2), 2048, 8192, E); }
    xcd_barrier(xbar);
    { pg8::EpiB<pg8::EM_PLAIN> E{}; E.O = (bf16_t*)(ws + WS_PP); E.ldc = 2048; E.aux1 = nullptr; E.aux2 = nullptr; E.plane = 0;
      run_gemm(lds, (const bf16_t*)(ws + WS_PB), (const bf16_t*)(ws + WS_WP), 2048, 256, E); }
    WG_LOCAL_HANDOFF();
    { pg8::EpiF<pg8::EF_PLE, false> E{}; E.O = P.out; E.res = P.out; E.pp = (const bf16_t*)(ws + WS_PP); E.ldc = 2048; E.rsq_in = (const float*)(ws + WS_RSQ2);
      run_gemm(lds, (const bf16_t*)(ws + WS_XN), (const bf16_t*)(ws + WS_WG), 2048, 2048, E); }
    xcd_barrier(xbar);
    rms_phase<2>(P.out, P.final_norm, nullptr, P.out, P, lds);
}

extern "C" void kernel_launch(void* const* d_in, const int* in_sizes, int n_in, void* d_out, int out_size, void* d_ws, size_t ws_size, hipStream_t stream) {
    static int grid_blocks = 0;
    if (grid_blocks == 0) {
        if (n_in != 19 || out_size != T_ * DM || ws_size < WS_END) { fprintf(stderr, "kernel_launch: unexpected shapes: n_in %d out %d ws %zu (need %zu)\n", n_in, out_size, ws_size, (size_t)WS_END); grid_blocks = -1; return; }
        int dev = 0, cus = 0, per_cu = 0;
        hipGetDevice(&dev); hipDeviceGetAttribute(&cus, hipDeviceAttributeMultiprocessorCount, dev);
        if (hipFuncSetAttribute((const void*)mega_fwd, hipFuncAttributeMaxDynamicSharedMemorySize, LDS_BYTES) != hipSuccess) { fprintf(stderr, "kernel_launch: hipFuncSetAttribute(%d B LDS) failed\n", LDS_BYTES); grid_blocks = -1; return; }
        if (hipOccupancyMaxActiveBlocksPerMultiprocessor(&per_cu, (const void*)mega_fwd, 512, LDS_BYTES) != hipSuccess || per_cu < 1) { fprintf(stderr, "kernel_launch: occupancy query gave %d\n", per_cu); per_cu = 1; }
        (void)hipGetLastError();
        grid_blocks = cus * per_cu;
        fprintf(stderr, "kernel_launch: grid %d (cus %d x %d)\n", grid_blocks, cus, per_cu);
    }
    if (grid_blocks < 0) return;
    Params P{};
    P.x = (const float*)d_in[0]; P.p = (const float*)d_in[1]; P.positions = (const int*)d_in[2]; P.attn_norm = (const float*)d_in[3]; P.w_in = (const float*)d_in[4];
    P.b_if = (const float*)d_in[5]; P.conv_w = (const float*)d_in[6]; P.conv_b = (const float*)d_in[7]; P.m_out_norm = (const float*)d_in[8]; P.w_up_m = (const float*)d_in[9];
    P.w_up_a = (const float*)d_in[10]; P.w_out = (const float*)d_in[11]; P.mlp_norm = (const float*)d_in[12]; P.w_ff1 = (const float*)d_in[13]; P.w_ff2 = (const float*)d_in[14];
    P.ple_norm = (const float*)d_in[15]; P.w_ple_gate = (const float*)d_in[16]; P.w_ple_proj = (const float*)d_in[17]; P.final_norm = (const float*)d_in[18];
    P.out = (float*)d_out; P.ws = (unsigned char*)d_ws;
    if (hipMemsetAsync((unsigned char*)d_ws + WS_XBAR, 0, 16384, stream) != hipSuccess) { fprintf(stderr, "kernel_launch: memset of the barrier words failed\n"); return; }
    void* args[] = {&P};
    hipError_t e = hipLaunchCooperativeKernel((const void*)mega_fwd, dim3(grid_blocks), dim3(512), args, LDS_BYTES, stream);
    if (e != hipSuccess) fprintf(stderr, "kernel_launch: cooperative launch failed: %s (grid %d)\n", hipGetErrorString(e), grid_blocks);
}
```
